# Optimizing an MI355X kernel written in HIP

```python
import math
import jax, jax.numpy as jnp
from jax import lax
import numpy as np

D_MODEL = 2048
BATCH = 4
SEQ = 2048
DEPTH = 4
DEC_BATCH = 32
DEC_SEQ = 8
PAST_LEN = 16384
PAGE_SIZE = 128

N_A = DEPTH // 2
N_B = DEPTH - N_A
RET_HEADS = 8
RET_DK = D_MODEL // RET_HEADS
RET_DV = 2 * D_MODEL // RET_HEADS
RET_CHUNK = 128
RET_ROPE_BASE = 10000.0
N_Q_HEADS = 32
N_KV_HEADS = 4
HEAD_DIM = D_MODEL // N_Q_HEADS
GQA_GROUPS = N_Q_HEADS // N_KV_HEADS
ROPE_DIM = HEAD_DIM // 4
ROPE_THETA = 500000.0
WINDOW = 128
ATT_BLOCK = 128
D_FF = 2 * D_MODEL
CONV_W = 3
N_MOD = 6
EPS = 1e-6
NEG_INF = -1e30

kernel_name = 'yoco_retention_swa_sink_convffn_step'


def rmsnorm(x, g):
    xf = x.astype(jnp.float32)
    y = xf * lax.rsqrt(jnp.mean(xf * xf, axis=-1, keepdims=True) + EPS)
    return (y * g.astype(jnp.float32)).astype(x.dtype)


def modulate(h, shift, scale):
    return h * (1 + scale[:, None, :]) + shift[:, None, :]


def rope(x, pos, dim, base):
    half = dim // 2
    inv = base ** (-jnp.arange(half, dtype=jnp.float32) * 2.0 / dim)
    ang = pos.astype(jnp.float32)[:, None] * inv[None, :]
    cos = jnp.cos(ang)[:, None, :]
    sin = jnp.sin(ang)[:, None, :]
    xr = x[..., :dim].astype(jnp.float32)
    x1, x2 = xr[..., :half], xr[..., half:]
    rot = jnp.concatenate([x1 * cos - x2 * sin, x2 * cos + x1 * sin], axis=-1).astype(x.dtype)
    return jnp.concatenate([rot, x[..., dim:]], axis=-1)


def retention_log_decay():
    return jnp.log(1.0 - jnp.exp2(-5.0 - jnp.arange(RET_HEADS, dtype=jnp.float32)))


def retention_chunk(q, k, v, s_prev, log_gamma):
    L = q.shape[1]
    idx = jnp.arange(L, dtype=jnp.float32)
    rel = idx[:, None] - idx[None, :]
    decay = jnp.where(rel >= 0, jnp.exp(jnp.maximum(rel, 0.0)[None] * log_gamma[:, None, None]), 0.0)
    scores = jnp.einsum('blhd,bmhd->bhlm', q, k) * decay[None]
    o = jnp.einsum('bhlm,bmhe->blhe', scores, v)
    q_decay = jnp.exp((idx + 1.0)[:, None] * log_gamma[None, :])
    o = o + jnp.einsum('blhd,bhde->blhe', q, s_prev) * q_decay[None, :, :, None]
    k_decay = jnp.exp((L - 1.0 - idx)[:, None] * log_gamma[None, :])
    s_new = (jnp.exp(L * log_gamma)[None, :, None, None] * s_prev
             + jnp.einsum('blhd,blhe->bhde', k * k_decay[None, :, :, None], v))
    return o, s_new


def retention_prompt(q, k, v, log_gamma):
    B, T = q.shape[:2]
    n = T // RET_CHUNK

    def to_chunks(a):
        return a.reshape(B, n, RET_CHUNK, *a.shape[2:]).swapaxes(0, 1)

    def step(s, qkv):
        o, s_new = retention_chunk(qkv[0], qkv[1], qkv[2], s, log_gamma)
        return s_new, o

    s0 = jnp.zeros((B, RET_HEADS, RET_DK, RET_DV), jnp.float32)
    s_fin, o = lax.scan(step, s0, (to_chunks(q), to_chunks(k), to_chunks(v)))
    return o.swapaxes(0, 1).reshape(B, T, RET_HEADS, RET_DV), s_fin


def retention_mixer(h, pos, w_in, gn_g, w_out, log_gamma, s_prev):
    B, T, _ = h.shape
    qk = RET_HEADS * RET_DK
    vd = RET_HEADS * RET_DV
    q, k, v, g = jnp.split(h @ w_in, [qk, 2 * qk, 2 * qk + vd], axis=-1)
    q = rope(q.reshape(B, T, RET_HEADS, RET_DK), pos, RET_DK, RET_ROPE_BASE).astype(jnp.float32)
    k = rope(k.reshape(B, T, RET_HEADS, RET_DK), pos, RET_DK, RET_ROPE_BASE).astype(jnp.float32) * RET_DK ** -0.5
    v = v.reshape(B, T, RET_HEADS, RET_DV).astype(jnp.float32)
    if s_prev is None:
        o, s_new = retention_prompt(q, k, v, log_gamma)
    else:
        o, s_new = retention_chunk(q, k, v, s_prev.astype(jnp.float32), log_gamma)
    mu = jnp.mean(o, axis=-1, keepdims=True)
    var = jnp.mean(jnp.square(o - mu), axis=-1, keepdims=True)
    o = ((o - mu) * lax.rsqrt(var + EPS)).reshape(B, T, vd) * gn_g.astype(jnp.float32)
    y = (jax.nn.silu(g.astype(jnp.float32)) * o).astype(h.dtype) @ w_out
    return y, s_new


def sink_attention(q, k, v, q_pos, k_pos, sinks):
    lead = q.shape[:-3]
    tq = q.shape[-3]
    qg = q.reshape(*lead, tq, N_KV_HEADS, GQA_GROUPS, HEAD_DIM)
    s = jnp.einsum('...qkgd,...skd->...kgqs', qg, k, preferred_element_type=jnp.float32) * HEAD_DIM ** -0.5
    rel = q_pos[..., :, None] - k_pos[..., None, :]
    ok = (rel >= 0) & (rel <= WINDOW) & (k_pos[..., None, :] >= 0)
    s = jnp.where(ok[..., None, None, :, :], s, NEG_INF)
    sink = sinks.astype(jnp.float32).reshape(N_KV_HEADS, GQA_GROUPS, 1, 1)
    m = jnp.maximum(jnp.max(s, axis=-1, keepdims=True), sink)
    p = jnp.exp(s - m)
    p = (p / (jnp.sum(p, axis=-1, keepdims=True) + jnp.exp(sink - m))).astype(v.dtype)
    o = jnp.einsum('...kgqs,...skd->...qkgd', p, v)
    return o.reshape(*lead, tq, N_Q_HEADS * HEAD_DIM)


def swa_prompt(q, k, v, sinks):
    B, T = q.shape[:2]
    nb = T // ATT_BLOCK
    qb = q.reshape(B, nb, ATT_BLOCK, N_Q_HEADS, HEAD_DIM)

    def with_prev(a):
        a = a.reshape(B, nb, ATT_BLOCK, N_KV_HEADS, HEAD_DIM)
        prev = jnp.pad(a, ((0, 0), (1, 0), (0, 0), (0, 0), (0, 0)))[:, :-1]
        return jnp.concatenate([prev, a], axis=2)

    pos = jnp.arange(T, dtype=jnp.int32).reshape(nb, ATT_BLOCK)
    k_pos = jnp.concatenate([pos - ATT_BLOCK, pos], axis=1)
    o = sink_attention(qb, with_prev(k), with_prev(v), pos, k_pos, sinks)
    return o.reshape(B, T, N_Q_HEADS * HEAD_DIM)


def conv_ffn(h, w_up, conv_w, conv_b, w_down, conv_state):
    u = h @ w_up
    B, T, C = u.shape
    past = jnp.zeros((B, CONV_W - 1, C), u.dtype) if conv_state is None else conv_state.astype(u.dtype)
    ext = jnp.concatenate([past, u], axis=1)
    acc = conv_b
    for i in range(CONV_W):
        acc = acc + conv_w[i] * ext[:, i:i + T]
    a, b = jnp.split(acc, 2, axis=-1)
    y = (jax.nn.silu(a) * b) @ w_down
    return y, ext[:, -(CONV_W - 1):]


def setup_inputs(seed: int = 0) -> dict:
    key = jax.random.key(seed)
    ks = iter(jax.random.split(key, 40))

    def nrm(shape, scale):
        return jax.random.normal(next(ks), shape, jnp.float32) * scale

    f2 = 2 * D_FF
    win_buf = min(WINDOW, PAST_LEN)
    d = D_MODEL
    return {
        'x_prompt': nrm((BATCH, SEQ, d), 1.0),
        'x_sample': nrm((DEC_BATCH, DEC_SEQ, d), 1.0),
        'state_ret': nrm((N_A, DEC_BATCH, RET_HEADS, RET_DK, RET_DV), 0.05),
        'cache_win_k': nrm((DEC_BATCH, win_buf, N_KV_HEADS, HEAD_DIM), 1.0),
        'cache_win_v': nrm((DEC_BATCH, win_buf, N_KV_HEADS, HEAD_DIM), 1.0),
        'state_conv': nrm((DEPTH, DEC_BATCH, CONV_W - 1, f2), 1.0),
        'c_prompt': nrm((BATCH, d), 1.0),
        'c_sample': nrm((DEC_BATCH, d), 1.0),
        'w_ada': nrm((DEPTH, d, N_MOD * d), 0.5 * d ** -0.5),
        'b_ada': nrm((DEPTH, N_MOD * d), 0.02),
        'norm_mix': 1.0 + nrm((DEPTH, d), 0.05),
        'norm_ffn': 1.0 + nrm((DEPTH, d), 0.05),
        'ret_w_in': nrm((N_A, d, 2 * RET_HEADS * RET_DK + 2 * RET_HEADS * RET_DV), d ** -0.5),
        'ret_gn': 1.0 + nrm((N_A, RET_HEADS * RET_DV), 0.05),
        'ret_w_out': nrm((N_A, RET_HEADS * RET_DV, d), (RET_HEADS * RET_DV) ** -0.5),
        'kv_norm': 1.0 + nrm((d,), 0.05),
        'kv_w_ada': nrm((d, 2 * d), 0.5 * d ** -0.5),
        'kv_b_ada': nrm((2 * d,), 0.02),
        'w_kv': nrm((d, 2 * N_KV_HEADS * HEAD_DIM), d ** -0.5),
        'att_w_q': nrm((N_B, d, N_Q_HEADS * HEAD_DIM), d ** -0.5),
        'att_sinks': nrm((N_B, N_Q_HEADS), 1.0),
        'att_w_o': nrm((N_B, N_Q_HEADS * HEAD_DIM, d), (N_Q_HEADS * HEAD_DIM) ** -0.5),
        'ffn_w_up': nrm((DEPTH, d, f2), d ** -0.5),
        'ffn_conv_w': nrm((DEPTH, CONV_W, f2), CONV_W ** -0.5),
        'ffn_conv_b': nrm((DEPTH, f2), 0.02),
        'ffn_w_down': nrm((DEPTH, D_FF, d), D_FF ** -0.5),
        'norm_f': 1.0 + nrm((d,), 0.05),
    }


def reference(x_prompt, x_sample, state_ret, cache_win_k, cache_win_v, state_conv, c_prompt, c_sample,
              w_ada, b_ada, norm_mix, norm_ffn, ret_w_in, ret_gn, ret_w_out,
              kv_norm, kv_w_ada, kv_b_ada, w_kv, att_w_q, att_sinks, att_w_o,
              ffn_w_up, ffn_conv_w, ffn_conv_b, ffn_w_down, norm_f):
    log_gamma = retention_log_decay()

    def trunk(x, c, pos, ret_in, win_k_in, win_v_in, conv_in):
        sample = ret_in is not None
        B, T, _ = x.shape
        cs = jax.nn.silu(c)
        ret_out, conv_out = [], []
        k_sh = v_sh = k_pos = win_k_out = win_v_out = None
        for l in range(DEPTH):
            if l == N_A:
                kv_shift, kv_scale = jnp.split(cs @ kv_w_ada + kv_b_ada, 2, axis=-1)
                hk = modulate(rmsnorm(x, kv_norm), kv_shift, kv_scale)
                k_new, v_new = jnp.split(hk @ w_kv, 2, axis=-1)
                k_new = rope(k_new.reshape(B, T, N_KV_HEADS, HEAD_DIM), pos, ROPE_DIM, ROPE_THETA)
                v_new = v_new.reshape(B, T, N_KV_HEADS, HEAD_DIM)
                if sample:
                    wb = win_k_in.shape[1]
                    k_sh = jnp.concatenate([win_k_in.astype(k_new.dtype), k_new], axis=1)
                    v_sh = jnp.concatenate([win_v_in.astype(v_new.dtype), v_new], axis=1)
                    k_pos = PAST_LEN - wb + jnp.arange(wb + T, dtype=jnp.int32)
                    win_k_out, win_v_out = k_sh[:, -wb:], v_sh[:, -wb:]
                else:
                    k_sh, v_sh = k_new, v_new
                    wp = min(WINDOW, T)
                    win_k_out, win_v_out = k_new[:, -wp:], v_new[:, -wp:]
            sh1, sc1, g1, sh2, sc2, g2 = jnp.split(cs @ w_ada[l] + b_ada[l], N_MOD, axis=-1)
            h = modulate(rmsnorm(x, norm_mix[l]), sh1, sc1)
            if l < N_A:
                y, s_new = retention_mixer(h, pos, ret_w_in[l], ret_gn[l], ret_w_out[l], log_gamma,
                                           ret_in[l] if sample else None)
                ret_out.append(s_new)
            else:
                j = l - N_A
                q = rope((h @ att_w_q[j]).reshape(B, T, N_Q_HEADS, HEAD_DIM), pos, ROPE_DIM, ROPE_THETA)
                if sample:
                    o = sink_attention(q, k_sh, v_sh, pos, k_pos, att_sinks[j])
                else:
                    o = swa_prompt(q, k_sh, v_sh, att_sinks[j])
                y = o @ att_w_o[j]
            x = x + g1[:, None, :] * y
            h = modulate(rmsnorm(x, norm_ffn[l]), sh2, sc2)
            y, c_state = conv_ffn(h, ffn_w_up[l], ffn_conv_w[l], ffn_conv_b[l], ffn_w_down[l],
                                  conv_in[l] if sample else None)
            conv_out.append(c_state)
            x = x + g2[:, None, :] * y
        return rmsnorm(x, norm_f), jnp.stack(ret_out), win_k_out, win_v_out, jnp.stack(conv_out)

    pos_p = jnp.arange(x_prompt.shape[1], dtype=jnp.int32)
    pos_s = PAST_LEN + jnp.arange(x_sample.shape[1], dtype=jnp.int32)
    y_prompt, ret_prompt, win_k_prompt, win_v_prompt, conv_prompt = trunk(
        x_prompt, c_prompt, pos_p, None, None, None, None)
    y_sample, ret_sample, win_k_sample, win_v_sample, conv_sample = trunk(
        x_sample, c_sample, pos_s, state_ret, cache_win_k, cache_win_v, state_conv)
    return (y_prompt, y_sample, ret_prompt, ret_sample, win_k_prompt, win_v_prompt,
            win_k_sample, win_v_sample, conv_prompt, conv_sample)
```

```cpp
#include <hip/hip_runtime.h>
#include <cstdio>
#include <cstdint>
namespace pg8 {
#define PG8_LAS __attribute__((address_space(3)))
typedef unsigned short bf16_t;
typedef short bf16x8 __attribute__((ext_vector_type(8)));
typedef float f32x4 __attribute__((ext_vector_type(4)));
typedef unsigned u32x4 __attribute__((ext_vector_type(4)));
constexpr int BM = 256, BK = 64, HALF = 128, HTB = HALF * BK * 2  , STAGE_BYTES = 8 * HTB, NXCD = 8, WGM = 8;

__host__ __device__ __forceinline__ int lds_byte(int r, int c) { const int st = (r >> 4) * 2 + (c >> 5), rr = r & 15, cc = c & 31, ob = rr * 64 + cc * 2; return st * 1024 + (ob ^ (((ob >> 9) & 1) << 5)); }
__host__ __device__ __forceinline__ void stage_rc(int b, int& R, int& C) { const int st = b / 1024, sb = b % 1024, swz = sb ^ (((sb >> 9) & 1) << 5); R = (st >> 1) * 16 + swz / 64; C = (st & 1) * 32 + (swz % 64) / 2; }
__host__ __device__ __forceinline__ int perm32(int rho) { const int n = rho >> 4, i = rho & 15; return 8 * (i >> 2) + 4 * n + (i & 3); }

struct Unit { int pm, pn; };
struct Gemm { const bf16_t* A; const bf16_t* Bt; int M, N, K; };

struct StaticOrder {
    int nM, nN, nwg, G, c;
    __host__ __device__ void init(int M, int N, int G_, int c_) { nM = M / BM; nN = N / BM; nwg = nM * nN; G = G_; c = c_; }
    __host__ __device__ bool next(int i, Unit& u) const {
        const long L = (long)i * G + c; if (L >= nwg) return false;
        int wgid = (int)L; { const int q = nwg / NXCD, r = nwg % NXCD, xcd = wgid % NXCD, off = wgid / NXCD; wgid = (xcd < r ? xcd * (q + 1) : r * (q + 1) + (xcd - r) * q) + off; }
        const int nig = WGM * nN, gid = wgid / nig, fm = gid * WGM, gsz = (nM - fm) < WGM ? (nM - fm) : WGM;
        u.pm = fm + ((wgid % nig) % gsz); u.pn = (wgid % nig) / gsz; return true;
    }
    __device__ __forceinline__ void a_ready(const Unit&) const {}
    __device__ __forceinline__ void done(const Unit&) const {}
};

__device__ __forceinline__ unsigned cvt_pk_bf16(float lo, float hi) { unsigned r; asm volatile("v_cvt_pk_bf16_f32 %0, %1, %2" : "=v"(r) : "v"(lo), "v"(hi)); return r; }
typedef float f32x2 __attribute__((ext_vector_type(2)));
__device__ __forceinline__ int bidx_of(int row) { return row < 8192 ? (row >> 11) : 4 + ((row - 8192) >> 3); }
__device__ __forceinline__ int pidx_of(int row) { return row < 8192 ? (row & 2047) : 2048 + (row & 7); }
__device__ __forceinline__ float silu_f(float x) { return x * __builtin_amdgcn_rcpf(1.0f + __builtin_amdgcn_exp2f(-1.4426950408889634f * x)); }
__device__ __forceinline__ u32x4 pack8(const f32x4 a, const f32x4 b) { u32x4 w; w.x = cvt_pk_bf16(a[0], a[1]); w.y = cvt_pk_bf16(a[2], a[3]); w.z = cvt_pk_bf16(b[0], b[1]); w.w = cvt_pk_bf16(b[2], b[3]); return w; }

struct EpiPlain {
    static constexpr bool PERM = true, AFTER_DRAIN = false;
    bf16_t* O; int ldc;
    __device__ __forceinline__ void operator()(const f32x4 (&acc)[2][2][4][2], const Unit& u, int wr, int wc, int fr, int fq) const {
        const int row0 = u.pm * BM + wr * 64 + fr, col0 = u.pn * BM + wc * 32 + 8 * fq;
#pragma unroll
        for (int ai = 0; ai < 2; ++ai)
#pragma unroll
            for (int m = 0; m < 4; ++m) { bf16_t* rowp = O + (size_t)(row0 + ai * HALF + m * 16) * ldc + col0;
#pragma unroll
                for (int bj = 0; bj < 2; ++bj) *(u32x4*)(rowp + bj * HALF) = pack8(acc[ai][bj][m][0], acc[ai][bj][m][1]); }
    }
};

struct EpiRetIn {
    static constexpr bool PERM = true, AFTER_DRAIN = false;
    bf16_t* O; const float* rt;
    __device__ __forceinline__ void operator()(const f32x4 (&acc)[2][2][4][2], const Unit& u, int wr, int wc, int fr, int fq) const {
        const int row0 = u.pm * BM + wr * 64 + fr, col0 = u.pn * BM + wc * 32 + 8 * fq;
        const int kind = u.pn < 16 ? 0 : (u.pn < 32 ? 1 : 2);
        const float ksc = (u.pn >= 8) ? 0.0625f : 1.0f;
#pragma unroll
        for (int ai = 0; ai < 2; ++ai)
#pragma unroll
            for (int m = 0; m < 4; ++m) {
                const int row = row0 + ai * HALF + m * 16; bf16_t* rowp = O + (size_t)row * 12288 + col0;
                f32x4 a0 = acc[ai][0][m][0], a1 = acc[ai][0][m][1], b0 = acc[ai][1][m][0], b1 = acc[ai][1][m][1];
                if (kind == 0) {
                    const float* tp = rt + ((size_t)pidx_of(row) * 128 + wc * 32 + 8 * fq) * 2;
                    const f32x4 t0 = *(const f32x4*)(tp), t1 = *(const f32x4*)(tp + 4), t2 = *(const f32x4*)(tp + 8), t3 = *(const f32x4*)(tp + 12);
                    f32x4 ra0, ra1, rb0, rb1;
                    ra0[0] = a0[0] * t0[0] - b0[0] * t0[1]; rb0[0] = b0[0] * t0[0] + a0[0] * t0[1];
                    ra0[1] = a0[1] * t0[2] - b0[1] * t0[3]; rb0[1] = b0[1] * t0[2] + a0[1] * t0[3];
                    ra0[2] = a0[2] * t1[0] - b0[2] * t1[1]; rb0[2] = b0[2] * t1[0] + a0[2] * t1[1];
                    ra0[3] = a0[3] * t1[2] - b0[3] * t1[3]; rb0[3] = b0[3] * t1[2] + a0[3] * t1[3];
                    ra1[0] = a1[0] * t2[0] - b1[0] * t2[1]; rb1[0] = b1[0] * t2[0] + a1[0] * t2[1];
                    ra1[1] = a1[1] * t2[2] - b1[1] * t2[3]; rb1[1] = b1[1] * t2[2] + a1[1] * t2[3];
                    ra1[2] = a1[2] * t3[0] - b1[2] * t3[1]; rb1[2] = b1[2] * t3[0] + a1[2] * t3[1];
                    ra1[3] = a1[3] * t3[2] - b1[3] * t3[3]; rb1[3] = b1[3] * t3[2] + a1[3] * t3[3];
                    a0 = ra0 * ksc; a1 = ra1 * ksc; b0 = rb0 * ksc; b1 = rb1 * ksc;
                } else if (kind == 2) {
#pragma unroll
                    for (int e = 0; e < 4; ++e) { a0[e] = silu_f(a0[e]); a1[e] = silu_f(a1[e]); b0[e] = silu_f(b0[e]); b1[e] = silu_f(b1[e]); }
                }
                *(u32x4*)(rowp) = pack8(a0, a1); *(u32x4*)(rowp + HALF) = pack8(b0, b1);
                if (m & 1) asm volatile("" ::: "memory");
            }
    }
};

struct EpiResid {
    static constexpr bool PERM = false, AFTER_DRAIN = false;
    float* X; const float* gate;
    __device__ __forceinline__ void operator()(const f32x4 (&acc)[2][2][4][2], const Unit& u, int wr, int wc, int fr, int fq) const {
        const int row0 = u.pm * BM + wr * 64 + fr, col0 = u.pn * BM + wc * 32 + 4 * fq;
#pragma unroll
        for (int ai = 0; ai < 2; ++ai)
#pragma unroll
            for (int m = 0; m < 4; ++m) {
                const int row = row0 + ai * HALF + m * 16; float* xr = X + (size_t)row * 2048 + col0; const float* gr = gate + (size_t)bidx_of(row) * 12288 + col0;
#pragma unroll
                for (int bj = 0; bj < 2; ++bj)
#pragma unroll
                    for (int n = 0; n < 2; ++n) { const f32x4 g4 = *(const f32x4*)(gr + bj * HALF + n * 16); f32x4 x4 = *(const f32x4*)(xr + bj * HALF + n * 16);
                        x4 = x4 + g4 * acc[ai][bj][m][n]; *(f32x4*)(xr + bj * HALF + n * 16) = x4; }
                if (m & 1) asm volatile("" ::: "memory");
            }
    }
};

struct EpiHead {
    static constexpr bool PERM = true, AFTER_DRAIN = false;
    bf16_t* O; int ldc; const float* rta;
    int rope_tiles;
    float* wk_p; float* wv_p; float* wk_s; float* wv_s;
    __device__ __forceinline__ void operator()(const f32x4 (&acc)[2][2][4][2], const Unit& u, int wr, int wc, int fr, int fq) const {
        const int row0 = u.pm * BM + wr * 64 + fr, col0 = u.pn * BM + wc * 32 + 8 * fq;
        const bool rope = (u.pn < rope_tiles) && ((wc & 1) == 0);
#pragma unroll
        for (int ai = 0; ai < 2; ++ai)
#pragma unroll
            for (int m = 0; m < 4; ++m) {
                const int row = row0 + ai * HALF + m * 16; bf16_t* rowp = O + (size_t)row * ldc + col0;
#pragma unroll
                for (int bj = 0; bj < 2; ++bj) {
                    f32x4 v0 = acc[ai][bj][m][0], v1 = acc[ai][bj][m][1];
                    if (rope) {
                        f32x4 p0, p1;
#pragma unroll
                        for (int e = 0; e < 4; ++e) { p0[e] = __shfl_xor(v0[e], 16); p1[e] = __shfl_xor(v1[e], 16); }
                        if (fq < 2) {
                            const float* tp = rta + (size_t)pidx_of(row) * 16;
                            const f32x4 t0 = *(const f32x4*)(tp), t1 = *(const f32x4*)(tp + 4), t2 = *(const f32x4*)(tp + 8), t3 = *(const f32x4*)(tp + 12);
                            const float sg = (fq == 0) ? -1.0f : 1.0f;
                            v0[0] = v0[0] * t0[0] + sg * p0[0] * t0[1]; v0[1] = v0[1] * t0[2] + sg * p0[1] * t0[3];
                            v0[2] = v0[2] * t1[0] + sg * p0[2] * t1[1]; v0[3] = v0[3] * t1[2] + sg * p0[3] * t1[3];
                            v1[0] = v1[0] * t2[0] + sg * p1[0] * t2[1]; v1[1] = v1[1] * t2[2] + sg * p1[1] * t2[3];
                            v1[2] = v1[2] * t3[0] + sg * p1[2] * t3[1]; v1[3] = v1[3] * t3[2] + sg * p1[3] * t3[3];
                        }
                    }
                    *(u32x4*)(rowp + bj * HALF) = pack8(v0, v1);
                    if (wk_p) {
                        const int c = wc * 32 + 8 * fq + bj * HALF; float* dst = nullptr;
                        if (row < 8192) { const int t = row & 2047; if (t >= 1920) dst = (u.pn == 0 ? wk_p : wv_p) + ((size_t)(row >> 11) * 128 + (t - 1920)) * 256 + c; }
                        else { const int sb = (row - 8192) >> 3, t = row & 7; dst = (u.pn == 0 ? wk_s : wv_s) + ((size_t)sb * 128 + 120 + t) * 256 + c; }
                        if (dst) { *(f32x4*)(dst) = v0; *(f32x4*)(dst + 4) = v1; }
                    }
                }
                if (m & 1) asm volatile("" ::: "memory");
            }
    }
};
template <class Epi, class Sched, bool ALIGN_EPI = false, bool SP2 = false>
__device__ __forceinline__ void gemm_phase(PG8_LAS unsigned char* lds, const Gemm g, const Sched& S, const Epi& E) {
    int tid_ = threadIdx.x; asm volatile("" : "+v"(tid_));
    const int tid = tid_, wid = __builtin_amdgcn_readfirstlane(tid >> 6), lane = tid & 63, wr = wid >> 2, wc = wid & 3, fr = lane & 15, fq = lane >> 4;
    const int K = g.K, nt = K / BK;
    unsigned voffA[2], voffB[2];
#pragma unroll
    for (int i = 0; i < 2; ++i) { int R, C; stage_rc(tid * 16 + i * 8192, R, C); const int Rb = Epi::PERM ? ((R & ~31) + perm32(R & 31)) : R;
        voffA[i] = (unsigned)(R * K + C) * 2u; voffB[i] = (unsigned)(Rb * K + C) * 2u; }
    const size_t kstep = (size_t)(BK * 2);
    const size_t hstep = (size_t)HALF * K * 2;
    const size_t tstep = 2 * hstep;
    const unsigned ldsw = (unsigned)wid * 1024u;
    const int aoff = lds_byte(wr * 64 + fr, fq * 8), boff = lds_byte(wc * 32 + fr, fq * 8);
#define PG8_SA(b, h) (((b) * 2 + (h)) * HTB)
#define PG8_SB(b, h) ((4 + (b) * 2 + (h)) * HTB)
#define PG8_STAGE(bufoff, gbase, voff) do { _Pragma("unroll") for (int _i = 0; _i < 2; ++_i) \
        __builtin_amdgcn_global_load_lds((const unsigned*)((const char*)(gbase) + (voff)[_i]), (PG8_LAS unsigned*)(lds + (bufoff) + ldsw + _i * 8192), 16, 0, 0); } while (0)
#define PG8_LDA(dst, b, h) do { _Pragma("unroll") for (int m = 0; m < 4; ++m) _Pragma("unroll") for (int k = 0; k < 2; ++k) dst[m][k] = *(const PG8_LAS bf16x8*)(lds + PG8_SA(b, h) + aoff + m * 2048 + k * 1024); } while (0)
#define PG8_LDB(dst, b, h) do { _Pragma("unroll") for (int n = 0; n < 2; ++n) _Pragma("unroll") for (int k = 0; k < 2; ++k) dst[n][k] = *(const PG8_LAS bf16x8*)(lds + PG8_SB(b, h) + boff + n * 2048 + k * 1024); } while (0)
#define PG8_MMA(ai, bj, At, Bt) do { __builtin_amdgcn_s_setprio(1); _Pragma("unroll") for (int m = 0; m < 4; ++m) _Pragma("unroll") for (int n = 0; n < 2; ++n) _Pragma("unroll") for (int k = 0; k < 2; ++k) \
        acc[ai][bj][m][n] = __builtin_amdgcn_mfma_f32_16x16x32_bf16(Bt[n][k], At[m][k], acc[ai][bj][m][n], 0, 0, 0); __builtin_amdgcn_s_setprio(0); } while (0)
#define PG8_WAIT_V(n) asm volatile("s_waitcnt vmcnt(" #n ")" ::: "memory")
#define PG8_WAIT_L(n) asm volatile("s_waitcnt lgkmcnt(" #n ")" ::: "memory")
#define PG8_BAR __builtin_amdgcn_s_barrier()
#define PG8_SCHED __builtin_amdgcn_sched_barrier(0)
    Unit cur, nxt; int ui = 0;
    if (!S.next(0, cur)) return;
    f32x4 acc[2][2][4][2];
#pragma unroll
    for (int a = 0; a < 2; ++a)
#pragma unroll
        for (int b = 0; b < 2; ++b)
#pragma unroll
            for (int m = 0; m < 4; ++m)
#pragma unroll
                for (int n = 0; n < 2; ++n) acc[a][b][m][n] = (f32x4){0.f, 0.f, 0.f, 0.f};
    bf16x8 At[4][2], B0[2][2], B1[2][2];
    const char* cA = (const char*)g.A + (size_t)cur.pm * tstep; const char* cB = (const char*)g.Bt + (size_t)cur.pn * tstep;
    S.a_ready(cur);
    if constexpr (SP2) {
        PG8_STAGE(PG8_SB(0, 0), cB, voffB); PG8_STAGE(PG8_SB(0, 1), cB + hstep, voffB); PG8_STAGE(PG8_SA(0, 0), cA, voffA); PG8_STAGE(PG8_SA(0, 1), cA + hstep, voffA);
        if (wr == 1) PG8_BAR;
        PG8_WAIT_V(2); PG8_BAR;
        PG8_STAGE(PG8_SB(1, 0), cB + kstep, voffB); PG8_STAGE(PG8_SA(1, 0), cA + kstep, voffA); PG8_STAGE(PG8_SB(1, 1), cB + hstep + kstep, voffB);
        PG8_WAIT_V(6); PG8_BAR;
    } else {
        PG8_STAGE(PG8_SB(0, 0), cB, voffB); PG8_STAGE(PG8_SA(0, 0), cA, voffA); PG8_STAGE(PG8_SB(0, 1), cB + hstep, voffB); PG8_STAGE(PG8_SA(0, 1), cA + hstep, voffA);
        if (wr == 1) PG8_BAR;
        PG8_WAIT_V(4); PG8_BAR;
        PG8_STAGE(PG8_SB(1, 0), cB + kstep, voffB); PG8_STAGE(PG8_SA(1, 0), cA + kstep, voffA); PG8_STAGE(PG8_SB(1, 1), cB + hstep + kstep, voffB);
        PG8_WAIT_V(6); PG8_BAR;
    }
    for (;;) {
        const bool has_next = S.next(ui + 1, nxt);
        const char* nA = has_next ? (const char*)g.A + (size_t)nxt.pm * tstep : cA; const char* nB = has_next ? (const char*)g.Bt + (size_t)nxt.pn * tstep : cB;
        for (int t = 0; t < nt; t += 2) {
            const bool last = (t == nt - 2);
            const char* a1 = cA + (size_t)(t + 1) * kstep;
            const char* a2 = last ? nA : cA + (size_t)(t + 2) * kstep; const char* b2 = last ? nB : cB + (size_t)(t + 2) * kstep;
            const char* a3 = a2 + kstep; const char* b3 = b2 + kstep;
            if (last && has_next) S.a_ready(nxt);
            if constexpr (SP2) {
            PG8_LDB(B0, 0, 0); PG8_LDB(B1, 0, 1); PG8_SCHED; PG8_LDA(At, 0, 0); PG8_STAGE(PG8_SA(1, 1), a1 + hstep, voffA);
            PG8_WAIT_V(8); PG8_WAIT_L(0); PG8_BAR; PG8_MMA(0, 0, At, B0); PG8_MMA(0, 1, At, B1); PG8_BAR; PG8_SCHED;
            PG8_LDA(At, 0, 1); PG8_STAGE(PG8_SB(0, 0), b2, voffB); PG8_STAGE(PG8_SB(0, 1), b2 + hstep, voffB); PG8_STAGE(PG8_SA(0, 0), a2, voffA);
            PG8_WAIT_V(8); PG8_WAIT_L(0); PG8_BAR; PG8_MMA(1, 0, At, B0); PG8_MMA(1, 1, At, B1); PG8_BAR; PG8_SCHED;
            PG8_LDB(B0, 1, 0); PG8_LDB(B1, 1, 1); PG8_SCHED; PG8_LDA(At, 1, 0); PG8_STAGE(PG8_SA(0, 1), a2 + hstep, voffA);
            PG8_WAIT_V(8); PG8_WAIT_L(0); PG8_BAR; PG8_MMA(0, 0, At, B0); PG8_MMA(0, 1, At, B1); PG8_BAR; PG8_SCHED;
            PG8_LDA(At, 1, 1); PG8_STAGE(PG8_SB(1, 0), b3, voffB); PG8_STAGE(PG8_SB(1, 1), b3 + hstep, voffB); PG8_STAGE(PG8_SA(1, 0), a3, voffA);
            PG8_WAIT_V(8); PG8_WAIT_L(0); PG8_BAR; PG8_MMA(1, 0, At, B0); PG8_MMA(1, 1, At, B1); PG8_BAR; PG8_SCHED;
            } else {
            PG8_LDB(B0, 0, 0); PG8_SCHED; PG8_LDA(At, 0, 0); PG8_STAGE(PG8_SA(1, 1), a1 + hstep, voffA);
            PG8_WAIT_L(8); PG8_BAR; PG8_WAIT_L(0); PG8_MMA(0, 0, At, B0); PG8_BAR; PG8_SCHED;
            PG8_LDB(B1, 0, 1); PG8_STAGE(PG8_SB(0, 0), b2, voffB);
            PG8_BAR; PG8_WAIT_L(0); PG8_MMA(0, 1, At, B1); PG8_BAR;
            PG8_LDA(At, 0, 1); PG8_STAGE(PG8_SA(0, 0), a2, voffA);
            PG8_BAR; PG8_WAIT_L(0); PG8_MMA(1, 0, At, B0); PG8_BAR; PG8_SCHED;
            PG8_STAGE(PG8_SB(0, 1), b2 + hstep, voffB);
            PG8_WAIT_V(6); PG8_BAR; PG8_MMA(1, 1, At, B1); PG8_BAR;
            PG8_LDB(B0, 1, 0); PG8_SCHED; PG8_LDA(At, 1, 0); PG8_STAGE(PG8_SA(0, 1), a2 + hstep, voffA);
            PG8_WAIT_L(8); PG8_BAR; PG8_WAIT_L(0); PG8_MMA(0, 0, At, B0); PG8_BAR; PG8_SCHED;
            PG8_LDB(B1, 1, 1); PG8_STAGE(PG8_SB(1, 0), b3, voffB);
            PG8_BAR; PG8_WAIT_L(0); PG8_MMA(0, 1, At, B1); PG8_BAR;
            PG8_LDA(At, 1, 1); PG8_STAGE(PG8_SA(1, 0), a3, voffA);
            PG8_BAR; PG8_WAIT_L(0); PG8_MMA(1, 0, At, B0); PG8_BAR; PG8_SCHED;
            PG8_STAGE(PG8_SB(1, 1), b3 + hstep, voffB);
            PG8_WAIT_V(6); PG8_BAR; PG8_MMA(1, 1, At, B1); PG8_BAR;
            }
        }
        if constexpr (ALIGN_EPI) { if (wr == 0) PG8_BAR; }
        if constexpr (!Epi::AFTER_DRAIN) { E(acc, cur, wr, wc, fr, fq); S.done(cur); }
        if (!has_next) break;
#pragma unroll
        for (int a = 0; a < 2; ++a)
#pragma unroll
            for (int b = 0; b < 2; ++b)
#pragma unroll
                for (int m = 0; m < 4; ++m)
#pragma unroll
                    for (int n = 0; n < 2; ++n) acc[a][b][m][n] = (f32x4){0.f, 0.f, 0.f, 0.f};
        cur = nxt; cA = nA; cB = nB; ++ui;
        if constexpr (ALIGN_EPI) { if (wr == 1) PG8_BAR; }
    }
    PG8_WAIT_V(0);
    if constexpr (!ALIGN_EPI) { if (wr == 0) PG8_BAR; }
    PG8_BAR;
    if constexpr (Epi::AFTER_DRAIN) { E.fused(acc, cur, wr, wc, fr, fq, lds, wid, lane); S.done(cur); }
#undef PG8_SA
#undef PG8_SB
#undef PG8_STAGE
#undef PG8_LDA
#undef PG8_LDB
#undef PG8_MMA
#undef PG8_WAIT_V
#undef PG8_WAIT_L
#undef PG8_BAR
#undef PG8_SCHED
}
}
#define GAS __attribute__((address_space(1)))
#define LAS __attribute__((address_space(3)))
typedef unsigned short bf16;
typedef unsigned v4u __attribute__((ext_vector_type(4)));
typedef float f32x4 __attribute__((ext_vector_type(4)));
typedef short bf16x8 __attribute__((ext_vector_type(8)));
typedef GAS unsigned gu32;
typedef GAS unsigned long long gu64;
#define RLX_AGENT __ATOMIC_RELAXED, __HIP_MEMORY_SCOPE_AGENT
#define LDS_WAIT() asm volatile("s_waitcnt lgkmcnt(0)" ::: "memory")
#define VM_WAIT() asm volatile("s_waitcnt vmcnt(0)" ::: "memory")
__device__ __forceinline__ unsigned long long rt() { return __builtin_amdgcn_s_memrealtime(); }
__device__ __forceinline__ unsigned f2bf(float f) { unsigned u = __builtin_bit_cast(unsigned, f); return (u + 0x7fffu + ((u >> 16) & 1u)) >> 16; }
__device__ __forceinline__ unsigned pk2(float lo, float hi) { return f2bf(lo) | (f2bf(hi) << 16); }

#define XB_TMO      128
#define XB_XCNT(j)  (256  + 64 * (j))
#define XB_XSUB(j)  (1280 + 64 * (j))
#define XB_XGEN(j)  (2304 + 64 * (j))
#define XB_TOP      3328
#define XB_TOPGEN   3392
#define XCD_BAR_WORDS 3456
#define XB_SPIN_CAP (1u << 18)

__device__ __forceinline__ unsigned xb_ld(unsigned* p)              { return __hip_atomic_load(p, __ATOMIC_RELAXED, __HIP_MEMORY_SCOPE_AGENT); }
__device__ __forceinline__ unsigned xb_add(unsigned* p, unsigned v) { return __hip_atomic_fetch_add(p, v, __ATOMIC_RELAXED, __HIP_MEMORY_SCOPE_AGENT); }
__device__ __forceinline__ unsigned xb_xcc_id() { return (unsigned)__builtin_amdgcn_s_getreg((3 << 11) | 20) & 0xFu; }
#define XB_SPIN(cond, bar) do { unsigned _sp = 0; while (cond) { __builtin_amdgcn_s_sleep(1); \
    if ((++_sp & 255u) == 0u) { if (xb_ld(&(bar)[XB_TMO])) break; if (_sp > XB_SPIN_CAP) { atomicAdd(&(bar)[XB_TMO], 1u); break; } } } } while (0)

struct XcdBarrier {
    unsigned* bar; unsigned x;
    volatile LAS unsigned* st;
};

__device__ __forceinline__ XcdBarrier xcd_barrier_post(unsigned* bar, volatile LAS unsigned* st) {
    XcdBarrier b; b.bar = bar; b.x = xb_xcc_id(); b.st = st;
    if (threadIdx.x == 0) (void)xb_add(&bar[XB_XCNT(b.x)], 1u);
    return b;
}
__device__ __forceinline__ void xcd_barrier_complete(unsigned* bar, unsigned x, unsigned& nloc, unsigned& nx) {
    const unsigned G = gridDim.x * gridDim.y * gridDim.z;
    unsigned sum, cnt, mine, sp = 0u;
    for (;;) {
        sum = 0u; cnt = 0u; mine = 0u;
#pragma unroll
        for (unsigned j = 0; j < 16; ++j) { const unsigned c = xb_ld(&bar[XB_XCNT(j)]); sum += c; cnt += (c > 0u) ? 1u : 0u; mine = (j == x) ? c : mine; }
        if (sum == G) break;
        __builtin_amdgcn_s_sleep(1);
        if ((++sp & 255u) == 0u) { if (xb_ld(&bar[XB_TMO])) break; if (sp > XB_SPIN_CAP) { atomicAdd(&bar[XB_TMO], 1u); break; } }
    }
    nloc = mine > 0u ? mine : 1u; nx = cnt > 0u ? cnt : 1u;
}

__device__ __forceinline__ void xcd_barrier(const XcdBarrier& b) {
    asm volatile("s_waitcnt vmcnt(0)" ::: "memory");
    __syncthreads();
    if (threadIdx.x == 0) {
        unsigned* bar = b.bar;
        __builtin_amdgcn_s_waitcnt(0);
        unsigned nloc = b.st[0], nx = b.st[1];
        if (nloc == 0u) { xcd_barrier_complete(bar, b.x, nloc, nx); b.st[0] = nloc; b.st[1] = nx; }
        const unsigned old = xb_add(&bar[XB_XSUB(b.x)], 1u);
        const unsigned gen = old / nloc;
        if (old + 1u == (gen + 1u) * nloc) {
            __builtin_amdgcn_fence(__ATOMIC_RELEASE, "agent");
            asm volatile("s_waitcnt vmcnt(0)" ::: "memory");
            const unsigned og = xb_add(&bar[XB_TOP], 1u);
            const unsigned tg = og / nx;
            if (og + 1u == (tg + 1u) * nx) xb_add(&bar[XB_TOPGEN], 1u);
            else XB_SPIN(xb_ld(&bar[XB_TOPGEN]) == tg, bar);
            __builtin_amdgcn_fence(__ATOMIC_ACQUIRE, "agent");
            xb_add(&bar[XB_XGEN(b.x)], 1u);
            asm volatile("s_waitcnt vmcnt(0)" ::: "memory");
        } else {
            XB_SPIN(xb_ld(&bar[XB_XGEN(b.x)]) == gen, bar);
            __builtin_amdgcn_fence(__ATOMIC_ACQUIRE, "agent");
            asm volatile("s_waitcnt vmcnt(0)" ::: "memory");
        }
    }
    __syncthreads();
}
__device__ __forceinline__ float wave_sum(float v) {
#pragma unroll
    for (int o = 1; o < 64; o <<= 1) v += __shfl_xor(v, o);
    return v;
}
__device__ __forceinline__ void p0_transpose_item(const float* W, int K, int N, bf16* WT, int row_off, LAS float* scr, int item, int lane) {
    const int nblk = N / 32, kb = item / nblk, nb = item % nblk, k0 = 64 * kb, n0 = 32 * nb;
#pragma unroll 8
    for (int i = 0; i < 32; ++i) { const int kk = 2 * i + (lane >> 5); scr[kk * 33 + (lane & 31)] = W[(size_t)(k0 + kk) * N + n0 + (lane & 31)]; }
    LDS_WAIT(); asm volatile("" ::: "memory");
    const int c = lane & 7;
#pragma unroll
    for (int j = 0; j < 4; ++j) { const int n = (lane >> 3) + 8 * j; const LAS float* s = scr + (8 * c) * 33 + n;
        v4u o; o.x = pk2(s[0 * 33], s[1 * 33]); o.y = pk2(s[2 * 33], s[3 * 33]); o.z = pk2(s[4 * 33], s[5 * 33]); o.w = pk2(s[6 * 33], s[7 * 33]);
        *(GAS v4u*)(WT + (size_t)(row_off + n0 + n) * K + k0 + 8 * c) = o; }
    LDS_WAIT(); asm volatile("" ::: "memory");
}

constexpr int NWAVES = 8;
constexpr int D = 2048, MP = 8192, MS = 256, MT = MP + MS, NMOD = 12288, NBM = 36;
constexpr int NQKVG = 12288, FF2 = 8192, DFF = 4096;
constexpr float EPS = 1e-6f;
constexpr size_t O_Y = 0, O_RETP = 17301504, O_RETS = 25690112, O_WKP = 92798976, O_WVP = 92930048, O_WKS = 93061120, O_WVS = 94109696, O_CONVP = 95158272, O_CONVS = 95420416, O_TOTAL = 97517568;
constexpr size_t MiB = 1u << 20;
constexpr size_t WS_CTL = 0, WS_MODS = 1 * MiB, WS_KVMODS = 8 * MiB, ZERO_BYTES = 9 * MiB;
constexpr size_t WS_RTR = 9 * MiB, WS_RTA = 12 * MiB;
constexpr size_t WS_X = 13 * MiB, WS_H = 79 * MiB, WS_HK = 112 * MiB, WS_QKVG = 145 * MiB, WS_U = 343 * MiB, WS_O = 475 * MiB, WS_A2 = 607 * MiB, WS_QA = 673 * MiB, WS_KV = 706 * MiB;
constexpr size_t WS_WIN = 715 * MiB, WS_WOUT = 811 * MiB, WS_WUP = 843 * MiB, WS_WDOWN = 971 * MiB, WS_WQ = 1035 * MiB, WS_WO = 1051 * MiB, WS_WKV = 1067 * MiB, WS_END = 1069 * MiB;
constexpr int CW_BAR = 4096;
constexpr int RING_BYTES = 131072, LDSCTL_OFF = RING_BYTES, MISC_OFF = LDSCTL_OFF + 320, LDS_BYTES = 147456;

struct Frame {
    LAS unsigned char* lds;
    volatile LAS unsigned* MISC;
    gu32* ctl;
    int tid, lane, wave, vcu, G;
    const float *x_prompt, *x_sample, *state_ret, *cache_k, *cache_v, *state_conv, *c_prompt, *c_sample, *w_ada, *b_ada, *norm_mix, *norm_ffn, *ret_w_in, *ret_gn, *ret_w_out,
                *kv_norm, *kv_w_ada, *kv_b_ada, *w_kv, *att_w_q, *att_sinks, *att_w_o, *ffn_w_up, *ffn_conv_w, *ffn_conv_b, *ffn_w_down, *norm_f;
    float* out;
    float *mods, *kvmods, *rtr, *rta, *X, *O;
    bf16 *H, *HK, *QKVG, *U, *A2, *QA, *KV, *WIN, *WOUT, *WUP, *WDOWN, *WQ, *WO, *WKV;
};
__device__ __forceinline__ unsigned cvtpk(float lo, float hi) { typedef float f32x2_t __attribute__((ext_vector_type(2))); typedef __bf16 bf16x2_t __attribute__((ext_vector_type(2)));
    f32x2_t v = {lo, hi}; bf16x2_t b = __builtin_convertvector(v, bf16x2_t); return __builtin_bit_cast(unsigned, b); }
__device__ __forceinline__ float bf2f(unsigned short h) { return __builtin_bit_cast(float, (unsigned)h << 16); }
__device__ __forceinline__ float bflo(unsigned w) { return __builtin_bit_cast(float, w << 16); }
__device__ __forceinline__ float bfhi(unsigned w) { return __builtin_bit_cast(float, w & 0xffff0000u); }
using pg8::bidx_of; using pg8::pidx_of;

__device__ __forceinline__ double exp_neg(double x) {
    const double n = __builtin_rint(x * 1.4426950408889634);
    double r = __builtin_fma(-n, 0.6931471805599453, x); r = __builtin_fma(-n, 2.3190468138462996e-17, r);
    double t = 1.0, s = 1.0;
#pragma unroll
    for (int k = 1; k <= 16; ++k) { t *= -r / (double)k; s += t; }
    return __builtin_ldexp(s, -(int)n);
}
__device__ __forceinline__ void sincos_f32ang(float ang, float& c, float& s) {
    const double a = (double)ang, n = __builtin_rint(a * 0.15915494309189535);
    double r = __builtin_fma(-n, 6.283185307179586, a); r = __builtin_fma(-n, 2.4492935982947064e-16, r);
    const double q = r * 0.25, q2 = q * q;
    double cs = 1.0, sn = 1.0, tc = 1.0, ts = 1.0;
#pragma unroll
    for (int k = 1; k <= 10; ++k) { tc *= -q2 / (double)((2 * k - 1) * (2 * k)); ts *= -q2 / (double)((2 * k) * (2 * k + 1)); cs += tc; sn += ts; }
    sn *= q;
#pragma unroll
    for (int k = 0; k < 2; ++k) { const double c2 = 2.0 * cs * cs - 1.0, s2 = 2.0 * sn * cs; cs = c2; sn = s2; }
    c = (float)cs; s = (float)sn;
}
__device__ __forceinline__ void p0_mods(Frame& F) {
    {
        LAS float* cs = (LAS float*)F.lds;
        for (int it = blockIdx.x; it < 416; it += F.G) {
            const int cb = it >> 3, kc = it & 7, k0 = kc * 256;
            const float* W; const float* bias; float* outp; int N, nb;
            if (cb < 48) { const int l = cb / 12; nb = cb % 12; W = F.w_ada + (size_t)l * D * NMOD; bias = F.b_ada + l * NMOD; outp = F.mods + (size_t)l * NBM * NMOD; N = NMOD; }
            else { nb = cb - 48; W = F.kv_w_ada; bias = F.kv_b_ada; outp = F.kvmods; N = 4096; }
            __syncthreads();
            for (int e = F.tid; e < NBM * 256; e += NWAVES * 64) { const int b = e >> 8, kk = e & 255;
                const float c = (b < 4) ? F.c_prompt[b * D + k0 + kk] : F.c_sample[(b - 4) * D + k0 + kk]; cs[e] = c / (1.0f + expf(-c)); }
            __syncthreads();
            const int col = nb * 1024 + F.wave * 128 + F.lane * 2;
            typedef float f32x2 __attribute__((ext_vector_type(2)));
            f32x2 acc[NBM];
#pragma unroll
            for (int b = 0; b < NBM; ++b) acc[b] = (f32x2){0.f, 0.f};
            const float* wp = W + (size_t)k0 * N + col;
            for (int kk = 0; kk < 256; kk += 4) {
                const f32x2 w0 = *(const f32x2*)(wp + (size_t)(kk + 0) * N), w1 = *(const f32x2*)(wp + (size_t)(kk + 1) * N), w2 = *(const f32x2*)(wp + (size_t)(kk + 2) * N), w3 = *(const f32x2*)(wp + (size_t)(kk + 3) * N);
#pragma unroll
                for (int b = 0; b < NBM; ++b) { const f32x4 c4 = *(const LAS f32x4*)(cs + b * 256 + kk); acc[b] += w0 * c4[0] + w1 * c4[1] + w2 * c4[2] + w3 * c4[3]; if ((b & 7) == 7) __builtin_amdgcn_sched_barrier(0); }
            }
            f32x2 bv = (f32x2){0.f, 0.f}; if (kc == 0) bv = *(const f32x2*)(bias + col);
#pragma unroll
            for (int b = 0; b < NBM; ++b) { float* o = outp + (size_t)b * N + col;
                __hip_atomic_fetch_add(o, acc[b][0] + bv[0], __ATOMIC_RELAXED, __HIP_MEMORY_SCOPE_AGENT); __hip_atomic_fetch_add(o + 1, acc[b][1] + bv[1], __ATOMIC_RELAXED, __HIP_MEMORY_SCOPE_AGENT); }
        }
        __syncthreads();
    }
}
__device__ __forceinline__ void p0_weights(Frame& F) {
    const int gw = F.vcu * NWAVES + F.wave, NGW = F.G * NWAVES;
    {
        LAS float* scr = (LAS float*)(F.lds + F.wave * 16384);
        constexpr int I_IN = 32 * 384, I_OUT = 64 * 64, I_KV = 32 * 16, I_Q = 32 * 64, I_UP = 32 * 256, I_DN = 64 * 64;
        constexpr int E0 = 2 * I_IN, E1 = E0 + 2 * I_OUT, E2 = E1 + I_KV, E3 = E2 + 2 * I_Q, E4 = E3 + 2 * I_Q, E5 = E4 + 4 * I_UP, E6 = E5 + 4 * I_DN;
        for (int it = gw; it < E6; it += NGW) {
            const float* W; bf16* WT; int K, N, r;
            if (it < E0)      { const int l = it / I_IN; r = it % I_IN; W = F.ret_w_in + (size_t)l * 2048 * 12288; WT = F.WIN + (size_t)l * 12288 * 2048; K = 2048; N = 12288; }
            else if (it < E1) { const int q = it - E0, l = q / I_OUT; r = q % I_OUT; W = F.ret_w_out + (size_t)l * 4096 * 2048; WT = F.WOUT + (size_t)l * 2048 * 4096; K = 4096; N = 2048; }
            else if (it < E2) { r = it - E1; W = F.w_kv; WT = F.WKV; K = 2048; N = 512; }
            else if (it < E3) { const int q = it - E2, l = q / I_Q; r = q % I_Q; W = F.att_w_q + (size_t)l * 2048 * 2048; WT = F.WQ + (size_t)l * 2048 * 2048; K = 2048; N = 2048; }
            else if (it < E4) { const int q = it - E3, l = q / I_Q; r = q % I_Q; W = F.att_w_o + (size_t)l * 2048 * 2048; WT = F.WO + (size_t)l * 2048 * 2048; K = 2048; N = 2048; }
            else if (it < E5) { const int q = it - E4, l = q / I_UP; r = q % I_UP; W = F.ffn_w_up + (size_t)l * 2048 * 8192; WT = F.WUP + (size_t)l * 8192 * 2048; K = 2048; N = 8192; }
            else              { const int q = it - E5, l = q / I_DN; r = q % I_DN; W = F.ffn_w_down + (size_t)l * 4096 * 2048; WT = F.WDOWN + (size_t)l * 2048 * 4096; K = 4096; N = 2048; }
            p0_transpose_item(W, K, N, WT, 0, scr, r, F.lane);
        }
    }
}
__device__ __forceinline__ void p0_tables(Frame& F) {
    const int gw = F.vcu * NWAVES + F.wave, NGW = F.G * NWAVES, gt = gw * 64 + F.lane, NGT = NGW * 64;
    for (int e = gt; e < 2056 * 136; e += NGT) {
        const int p = e / 136, i = e % 136; const float pos = (float)(p < 2048 ? p : 16384 + (p - 2048));
        float c, s;
        if (i < 128) { const float inv = (float)exp_neg((double)i * (9.210340371976184 / 128.0)); sincos_f32ang(pos * inv, c, s); F.rtr[((size_t)p * 128 + i) * 2] = c; F.rtr[((size_t)p * 128 + i) * 2 + 1] = s; }
        else { const int j = i - 128; const float inv = (float)exp_neg((double)j * (13.122363377404328 / 8.0)); sincos_f32ang(pos * inv, c, s); F.rta[((size_t)p * 8 + j) * 2] = c; F.rta[((size_t)p * 8 + j) * 2 + 1] = s; }
    }
}
__device__ __forceinline__ void p0_copies(Frame& F) {
    const int gw = F.vcu * NWAVES + F.wave, NGW = F.G * NWAVES, gt = gw * 64 + F.lane, NGT = NGW * 64;
    for (int e = gt; e < MT * D / 4; e += NGT) { const int pe = MP * D / 4;
        const f32x4 v = e < pe ? ((const f32x4*)F.x_prompt)[e] : ((const f32x4*)F.x_sample)[e - pe]; ((f32x4*)F.X)[e] = v; }
    for (int e = gt; e < 32 * 120 * 64; e += NGT) { const int sb = e / (120 * 64), r = e % (120 * 64);
        ((f32x4*)(F.out + O_WKS))[(size_t)sb * 128 * 64 + r] = ((const f32x4*)F.cache_k)[(size_t)sb * 128 * 64 + 8 * 64 + r];
        ((f32x4*)(F.out + O_WVS))[(size_t)sb * 128 * 64 + r] = ((const f32x4*)F.cache_v)[(size_t)sb * 128 * 64 + 8 * 64 + r]; }
}

__device__ __forceinline__ void t_norm_mod(Frame& F, const float* gv, const float* sh, const float* sc, int mstride, bf16* outp,
                                           const float* gv2, const float* sh2, const float* sc2, int mstride2, bf16* outp2) {
    const int gw = F.vcu * NWAVES + F.wave, NGW = F.G * NWAVES;
    for (int row = gw; row < MT; row += NGW) {
        const float* xr = F.X + (size_t)row * D + 4 * F.lane;
        f32x4 v[8]; float ss = 0.f;
#pragma unroll
        for (int j = 0; j < 8; ++j) { v[j] = *(const f32x4*)(xr + 256 * j); ss += (v[j][0] * v[j][0] + v[j][1] * v[j][1]) + (v[j][2] * v[j][2] + v[j][3] * v[j][3]); }
        const float rstd = 1.0f / sqrtf(wave_sum(ss) * (1.0f / D) + EPS);
        const int b = bidx_of(row);
#pragma unroll
        for (int j = 0; j < 8; ++j) { const int c = 4 * F.lane + 256 * j;
            const f32x4 g4 = *(const f32x4*)(gv + c), s4 = *(const f32x4*)(sc + (size_t)b * mstride + c), h4 = *(const f32x4*)(sh + (size_t)b * mstride + c);
            const f32x4 o = v[j] * rstd * g4 * (s4 + 1.0f) + h4;
            typedef unsigned u32x2 __attribute__((ext_vector_type(2)));
            u32x2 w; w.x = cvtpk(o[0], o[1]); w.y = cvtpk(o[2], o[3]); *(u32x2*)(outp + (size_t)row * D + c) = w; }
        if (gv2) {
#pragma unroll
            for (int j = 0; j < 8; ++j) { const int c = 4 * F.lane + 256 * j;
                const f32x4 g4 = *(const f32x4*)(gv2 + c), s4 = *(const f32x4*)(sc2 + (size_t)b * mstride2 + c), h4 = *(const f32x4*)(sh2 + (size_t)b * mstride2 + c);
                const f32x4 o = v[j] * rstd * g4 * (s4 + 1.0f) + h4;
                typedef unsigned u32x2 __attribute__((ext_vector_type(2)));
                u32x2 w; w.x = cvtpk(o[0], o[1]); w.y = cvtpk(o[2], o[3]); *(u32x2*)(outp2 + (size_t)row * D + c) = w; }
        }
    }
}
__device__ __forceinline__ void t_final_norm(Frame& F) {
    const int gw = F.vcu * NWAVES + F.wave, NGW = F.G * NWAVES;
    for (int row = gw; row < MT; row += NGW) {
        const float* xr = F.X + (size_t)row * D + 4 * F.lane;
        f32x4 v[8]; float ss = 0.f;
#pragma unroll
        for (int j = 0; j < 8; ++j) { v[j] = *(const f32x4*)(xr + 256 * j); ss += (v[j][0] * v[j][0] + v[j][1] * v[j][1]) + (v[j][2] * v[j][2] + v[j][3] * v[j][3]); }
        const float rstd = 1.0f / sqrtf(wave_sum(ss) * (1.0f / D) + EPS);
#pragma unroll
        for (int j = 0; j < 8; ++j) { const int c = 4 * F.lane + 256 * j; *(f32x4*)(F.out + O_Y + (size_t)row * D + c) = v[j] * rstd * *(const f32x4*)(F.norm_f + c); }
    }
}
__device__ __forceinline__ void t_gn_gate(Frame& F, int l) {
    const int gw = F.vcu * NWAVES + F.wave, NGW = F.G * NWAVES;
    const float* gn = F.ret_gn + (size_t)l * 4096;
    for (int it = gw; it < MT * 8; it += NGW) {
        const int row = it >> 3, h = it & 7, c = h * 512 + 8 * F.lane;
        const float* op = F.O + (size_t)row * 4096 + c;
        const f32x4 o0 = *(const f32x4*)(op), o1 = *(const f32x4*)(op + 4);
        const v4u gq = *(const v4u*)(F.QKVG + (size_t)row * NQKVG + 8192 + c);
        const f32x4 g0 = *(const f32x4*)(gn + c), g1 = *(const f32x4*)(gn + c + 4);
        const float mu = wave_sum((o0[0] + o0[1]) + (o0[2] + o0[3]) + (o1[0] + o1[1]) + (o1[2] + o1[3])) * (1.0f / 512.0f);
        const f32x4 d0 = o0 - mu, d1 = o1 - mu;
        const float var = wave_sum((d0[0] * d0[0] + d0[1] * d0[1]) + (d0[2] * d0[2] + d0[3] * d0[3]) + (d1[0] * d1[0] + d1[1] * d1[1]) + (d1[2] * d1[2] + d1[3] * d1[3])) * (1.0f / 512.0f);
        const float rstd = 1.0f / sqrtf(var + EPS);
        const f32x4 y0 = d0 * rstd * g0, y1 = d1 * rstd * g1;
        v4u w;
        w.x = cvtpk(bflo(gq.x) * y0[0], bfhi(gq.x) * y0[1]); w.y = cvtpk(bflo(gq.y) * y0[2], bfhi(gq.y) * y0[3]);
        w.z = cvtpk(bflo(gq.z) * y1[0], bfhi(gq.z) * y1[1]); w.w = cvtpk(bflo(gq.w) * y1[2], bfhi(gq.w) * y1[3]);
        *(v4u*)(F.A2 + (size_t)row * 4096 + c) = w;
    }
}
__device__ __forceinline__ void t_conv_gate(Frame& F, int l) {
    const int gw = F.vcu * NWAVES + F.wave, NGW = F.G * NWAVES;
    const float* cw = F.ffn_conv_w + (size_t)l * 3 * FF2; const float* cbv = F.ffn_conv_b + (size_t)l * FF2;
    for (int it = gw; it < (MT / 8) * 8; it += NGW) {
        const int run = it >> 3, cc = it & 7, r0 = run * 8, j0 = cc * 512 + 8 * F.lane;
        float pa2[8], pa1[8], pb2[8], pb1[8];
        const bool sample = r0 >= MP; const int t0 = sample ? 0 : (r0 & 2047);
        if (sample) {
            const float* sp = F.state_conv + ((size_t)(l * 32 + ((r0 - MP) >> 3)) * 2) * FF2;
#pragma unroll
            for (int e = 0; e < 8; ++e) { pa2[e] = sp[j0 + e]; pb2[e] = sp[4096 + j0 + e]; pa1[e] = sp[FF2 + j0 + e]; pb1[e] = sp[FF2 + 4096 + j0 + e]; }
        } else if (t0 == 0) {
#pragma unroll
            for (int e = 0; e < 8; ++e) { pa2[e] = 0.f; pb2[e] = 0.f; pa1[e] = 0.f; pb1[e] = 0.f; }
        } else {
            const v4u a2 = *(const v4u*)(F.U + (size_t)(r0 - 2) * FF2 + j0), b2 = *(const v4u*)(F.U + (size_t)(r0 - 2) * FF2 + 4096 + j0);
            const v4u a1 = *(const v4u*)(F.U + (size_t)(r0 - 1) * FF2 + j0), b1 = *(const v4u*)(F.U + (size_t)(r0 - 1) * FF2 + 4096 + j0);
#pragma unroll
            for (int q = 0; q < 4; ++q) { pa2[2 * q] = bflo(a2[q]); pa2[2 * q + 1] = bfhi(a2[q]); pb2[2 * q] = bflo(b2[q]); pb2[2 * q + 1] = bfhi(b2[q]);
                                          pa1[2 * q] = bflo(a1[q]); pa1[2 * q + 1] = bfhi(a1[q]); pb1[2 * q] = bflo(b1[q]); pb1[2 * q + 1] = bfhi(b1[q]); }
        }
        float wa[3][8], wb[3][8], ba[8], bb[8];
#pragma unroll
        for (int i = 0; i < 3; ++i) { const f32x4 x0 = *(const f32x4*)(cw + i * FF2 + j0), x1 = *(const f32x4*)(cw + i * FF2 + j0 + 4), y0 = *(const f32x4*)(cw + i * FF2 + 4096 + j0), y1 = *(const f32x4*)(cw + i * FF2 + 4096 + j0 + 4);
#pragma unroll
            for (int e = 0; e < 4; ++e) { wa[i][e] = x0[e]; wa[i][4 + e] = x1[e]; wb[i][e] = y0[e]; wb[i][4 + e] = y1[e]; } }
        { const f32x4 x0 = *(const f32x4*)(cbv + j0), x1 = *(const f32x4*)(cbv + j0 + 4), y0 = *(const f32x4*)(cbv + 4096 + j0), y1 = *(const f32x4*)(cbv + 4096 + j0 + 4);
#pragma unroll
            for (int e = 0; e < 4; ++e) { ba[e] = x0[e]; ba[4 + e] = x1[e]; bb[e] = y0[e]; bb[4 + e] = y1[e]; } }
        float* cst = nullptr;
        if (sample) cst = F.out + O_CONVS + ((size_t)(l * 32 + ((r0 - MP) >> 3)) * 2) * FF2;
        else if (t0 == 2040) cst = F.out + O_CONVP + ((size_t)(l * 4 + (r0 >> 11)) * 2) * FF2;
#pragma unroll
        for (int t = 0; t < 8; ++t) {
            const v4u ua = *(const v4u*)(F.U + (size_t)(r0 + t) * FF2 + j0), ub = *(const v4u*)(F.U + (size_t)(r0 + t) * FF2 + 4096 + j0);
            float ca[8], cb2[8], act[8];
#pragma unroll
            for (int q = 0; q < 4; ++q) { ca[2 * q] = bflo(ua[q]); ca[2 * q + 1] = bfhi(ua[q]); cb2[2 * q] = bflo(ub[q]); cb2[2 * q + 1] = bfhi(ub[q]); }
#pragma unroll
            for (int e = 0; e < 8; ++e) {
                const float za = ba[e] + wa[0][e] * pa2[e] + wa[1][e] * pa1[e] + wa[2][e] * ca[e];
                const float zb = bb[e] + wb[0][e] * pb2[e] + wb[1][e] * pb1[e] + wb[2][e] * cb2[e];
                act[e] = pg8::silu_f(za) * zb;
                pa2[e] = pa1[e]; pa1[e] = ca[e]; pb2[e] = pb1[e]; pb1[e] = cb2[e];
            }
            v4u w; w.x = cvtpk(act[0], act[1]); w.y = cvtpk(act[2], act[3]); w.z = cvtpk(act[4], act[5]); w.w = cvtpk(act[6], act[7]);
            *(v4u*)(F.A2 + (size_t)(r0 + t) * DFF + j0) = w;
            if (cst && t >= 6) { float* d = cst + (size_t)(t - 6) * FF2;
                *(f32x4*)(d + j0) = (f32x4){ca[0], ca[1], ca[2], ca[3]}; *(f32x4*)(d + j0 + 4) = (f32x4){ca[4], ca[5], ca[6], ca[7]};
                *(f32x4*)(d + 4096 + j0) = (f32x4){cb2[0], cb2[1], cb2[2], cb2[3]}; *(f32x4*)(d + 4096 + j0 + 4) = (f32x4){cb2[4], cb2[5], cb2[6], cb2[7]}; }
        }
    }
}

typedef unsigned u32x2_t __attribute__((ext_vector_type(2)));
__device__ __forceinline__ void ret_prompt_phase(Frame& F, int l) {
    LAS unsigned char* L = F.lds;
    constexpr int KS_STRIDE = 528, VT_STRIDE = 272, ST_STRIDE = 528, KS_OFF = 0, VT_OFF = 128 * KS_STRIDE, ST_OFF = VT_OFF + 64 * VT_STRIDE;
    static_assert(ST_OFF + 64 * ST_STRIDE <= RING_BYTES, "retention LDS");
    const int w = F.wave, lane = F.lane, fr = lane & 15, g = lane >> 4, tid = F.tid;
    const int rb = (w < 4) ? w : 11 - w;
    for (int unit = F.vcu; unit < 256; unit += F.G) {
        const int eb = unit & 7, h = (unit >> 3) & 7, b = unit >> 6;
        const float lg = log2f(1.0f - exp2f(-5.0f - (float)h));
        const float g128 = exp2f(128.0f * lg);
        f32x4 Sacc[2][4];
#pragma unroll
        for (int a = 0; a < 2; ++a)
#pragma unroll
            for (int e = 0; e < 4; ++e) Sacc[a][e] = (f32x4){0.f, 0.f, 0.f, 0.f};
        const bf16* Qh = F.QKVG + h * 256; const bf16* Kh = F.QKVG + 2048 + h * 256; const bf16* Vh = F.QKVG + 4096 + h * 512 + eb * 64;
        for (int c = 0; c < 16; ++c) {
            const size_t r0 = (size_t)b * 2048 + 128 * c;
            v4u kreg[8], vreg[2]; bf16x8 qf[8];
#pragma unroll
            for (int i = 0; i < 8; ++i) { const int p = tid + 512 * i; kreg[i] = *(const v4u*)(Kh + (r0 + (p >> 5)) * NQKVG + (p & 31) * 8); }
#pragma unroll
            for (int i = 0; i < 2; ++i) { const int p = tid + 512 * i; vreg[i] = *(const v4u*)(Vh + (r0 + (p & 127)) * NQKVG + (p >> 7) * 8); }
#pragma unroll
            for (int ks = 0; ks < 8; ++ks) qf[ks] = *(const bf16x8*)(Qh + (r0 + 16 * rb + fr) * NQKVG + 32 * ks + 8 * g);
            __syncthreads();
#pragma unroll
            for (int i = 0; i < 8; ++i) { const int p = tid + 512 * i; *(LAS v4u*)(L + KS_OFF + (p >> 5) * KS_STRIDE + (p & 31) * 16) = kreg[i]; }
#pragma unroll
            for (int i = 0; i < 2; ++i) { const int p = tid + 512 * i, m = p & 127, e8 = (p >> 7) * 8; const float kd = exp2f((float)(127 - m) * lg);
#pragma unroll
                for (int q = 0; q < 4; ++q) { const unsigned pk = cvtpk(bflo(vreg[i][q]) * kd, bfhi(vreg[i][q]) * kd);
                    *(LAS unsigned short*)(L + VT_OFF + (e8 + 2 * q) * VT_STRIDE + m * 2) = (unsigned short)(pk & 0xffffu);
                    *(LAS unsigned short*)(L + VT_OFF + (e8 + 2 * q + 1) * VT_STRIDE + m * 2) = (unsigned short)(pk >> 16); } }
#pragma unroll
            for (int dt = 0; dt < 2; ++dt)
#pragma unroll
                for (int et = 0; et < 4; ++et) { Sacc[dt][et] = Sacc[dt][et] * g128;
                    u32x2_t sw; sw.x = cvtpk(Sacc[dt][et][0], Sacc[dt][et][1]); sw.y = cvtpk(Sacc[dt][et][2], Sacc[dt][et][3]);
                    *(LAS u32x2_t*)(L + ST_OFF + (16 * et + fr) * ST_STRIDE + (32 * w + 16 * dt + 4 * g) * 2) = sw; }
            __syncthreads();
            f32x4 P[8];
#pragma unroll
            for (int t = 0; t < 8; ++t) {
                P[t] = (f32x4){0.f, 0.f, 0.f, 0.f};
                if (t <= rb) {
#pragma unroll
                    for (int ks = 0; ks < 8; ++ks) { const bf16x8 kf = *(const LAS bf16x8*)(L + KS_OFF + (16 * t + fr) * KS_STRIDE + (32 * ks + 8 * g) * 2);
                        P[t] = __builtin_amdgcn_mfma_f32_16x16x32_bf16(kf, qf[ks], P[t], 0, 0, 0); }
                    if (t == rb) {
#pragma unroll
                        for (int i = 0; i < 4; ++i) if (4 * g + i > fr) P[t][i] = 0.f;
                    }
                }
            }
            bf16x8 pa[4];
#pragma unroll
            for (int tp = 0; tp < 4; ++tp) { v4u pw; pw.x = cvtpk(P[2 * tp][0], P[2 * tp][1]); pw.y = cvtpk(P[2 * tp][2], P[2 * tp][3]); pw.z = cvtpk(P[2 * tp + 1][0], P[2 * tp + 1][1]); pw.w = cvtpk(P[2 * tp + 1][2], P[2 * tp + 1][3]);
                pa[tp] = __builtin_bit_cast(bf16x8, pw); }
            const float arow = exp2f((float)(16 * rb + fr - 127) * lg);
            float* orow = F.O + (r0 + 16 * rb + fr) * 4096 + h * 512 + eb * 64 + 4 * g;
#pragma unroll
            for (int et = 0; et < 4; ++et) {
                f32x4 oacc = (f32x4){0.f, 0.f, 0.f, 0.f};
#pragma unroll
                for (int tp = 0; tp < 4; ++tp) if (2 * tp <= rb) {
                    const LAS unsigned char* vp = L + VT_OFF + (16 * et + fr) * VT_STRIDE + (32 * tp + 4 * g) * 2;
                    const u32x2_t v0 = *(const LAS u32x2_t*)(vp), v1 = *(const LAS u32x2_t*)(vp + 32);
                    const v4u vv = (v4u){v0.x, v0.y, v1.x, v1.y};
                    oacc = __builtin_amdgcn_mfma_f32_16x16x32_bf16(__builtin_bit_cast(bf16x8, vv), pa[tp], oacc, 0, 0, 0); }
#pragma unroll
                for (int ks = 0; ks < 8; ++ks) { const bf16x8 sf = *(const LAS bf16x8*)(L + ST_OFF + (16 * et + fr) * ST_STRIDE + (32 * ks + 8 * g) * 2);
                    oacc = __builtin_amdgcn_mfma_f32_16x16x32_bf16(sf, qf[ks], oacc, 0, 0, 0); }
                *(f32x4*)(orow + 16 * et) = oacc * arow;
            }
#pragma unroll
            for (int tp = 0; tp < 4; ++tp) {
                bf16x8 vf[4];
#pragma unroll
                for (int et = 0; et < 4; ++et) { const LAS unsigned char* vp = L + VT_OFF + (16 * et + fr) * VT_STRIDE + (32 * tp + 4 * g) * 2;
                    const u32x2_t v0 = *(const LAS u32x2_t*)(vp), v1 = *(const LAS u32x2_t*)(vp + 32); const v4u vv = (v4u){v0.x, v0.y, v1.x, v1.y}; vf[et] = __builtin_bit_cast(bf16x8, vv); }
#pragma unroll
                for (int dt = 0; dt < 2; ++dt) {
                    const LAS unsigned char* kp = L + KS_OFF + (32 * tp + 4 * g) * KS_STRIDE + (32 * w + 16 * dt + fr) * 2;
                    unsigned short kk[8];
#pragma unroll
                    for (int j = 0; j < 4; ++j) { kk[j] = *(const LAS unsigned short*)(kp + j * KS_STRIDE); kk[4 + j] = *(const LAS unsigned short*)(kp + (16 + j) * KS_STRIDE); }
                    v4u kw; kw.x = (unsigned)kk[0] | ((unsigned)kk[1] << 16); kw.y = (unsigned)kk[2] | ((unsigned)kk[3] << 16); kw.z = (unsigned)kk[4] | ((unsigned)kk[5] << 16); kw.w = (unsigned)kk[6] | ((unsigned)kk[7] << 16);
                    const bf16x8 ktf = __builtin_bit_cast(bf16x8, kw);
#pragma unroll
                    for (int et = 0; et < 4; ++et) Sacc[dt][et] = __builtin_amdgcn_mfma_f32_16x16x32_bf16(ktf, vf[et], Sacc[dt][et], 0, 0, 0);
                }
            }
        }
        float* sp = F.out + O_RETP + ((size_t)((l * 4 + b) * 8 + h) * 256) * 512 + eb * 64;
#pragma unroll
        for (int dt = 0; dt < 2; ++dt)
#pragma unroll
            for (int et = 0; et < 4; ++et)
#pragma unroll
                for (int i = 0; i < 4; ++i) sp[(size_t)(32 * w + 16 * dt + 4 * g + i) * 512 + 16 * et + fr] = Sacc[dt][et][i];
    }
}

__device__ __forceinline__ void ret_sample_phase(Frame& F, int l) {
    LAS float* Lq = (LAS float*)F.lds;
    LAS float* Lk = Lq + 2048;
    LAS float* Lt = Lk + 2048;
    LAS float* La = Lt + 4096;
    LAS float* Lr = La + 64;
    const int tid = F.tid, e4 = tid & 127, dq = tid >> 7, e = 4 * e4;
    for (int unit = F.vcu; unit < 256; unit += F.G) {
        const int sb = unit >> 3, h = unit & 7;
        const float lg = log2f(1.0f - exp2f(-5.0f - (float)h));
        const size_t r0 = (size_t)MP + 8 * sb;
        __syncthreads();
        for (int i = tid; i < 4096; i += 512) { const int which = i >> 11, t = (i >> 8) & 7, d = i & 255;
            const float v = bf2f(F.QKVG[(r0 + t) * NQKVG + which * 2048 + h * 256 + d]); (which ? Lk : Lq)[t * 256 + d] = v; }
        __syncthreads();
        if (tid < 64) { const int t = tid >> 3, m = tid & 7; float s = 0.f;
            for (int d = 0; d < 256; ++d) s += Lq[t * 256 + d] * Lk[m * 256 + d];
            La[tid] = (m <= t) ? s * exp2f((float)(t - m) * lg) : 0.f; }
        for (int i = tid; i < 4096; i += 512) { const int d = i >> 4, j = i & 15;
            Lt[i] = (j < 8) ? Lq[j * 256 + d] * exp2f((float)(j + 1) * lg) : Lk[(j - 8) * 256 + d] * exp2f((float)(15 - j) * lg); }
        f32x4 vv[8];
#pragma unroll
        for (int m = 0; m < 8; ++m) { typedef unsigned u32x2 __attribute__((ext_vector_type(2)));
            const u32x2 q = *(const u32x2*)(F.QKVG + (r0 + m) * NQKVG + 4096 + h * 512 + e); vv[m] = (f32x4){bflo(q.x), bfhi(q.x), bflo(q.y), bfhi(q.y)}; }
        __syncthreads();
        const float g8 = exp2f(8.0f * lg);
        const float* Sin = F.state_ret + ((size_t)((l * 32 + sb) * 8 + h) * 256) * 512 + e;
        float* Sout = F.out + O_RETS + ((size_t)((l * 32 + sb) * 8 + h) * 256) * 512 + e;
        f32x4 oacc[8];
#pragma unroll
        for (int t = 0; t < 8; ++t) oacc[t] = (f32x4){0.f, 0.f, 0.f, 0.f};
        for (int i0 = 0; i0 < 64; i0 += 4) {
            f32x4 s[4];
#pragma unroll
            for (int u = 0; u < 4; ++u) s[u] = *(const f32x4*)(Sin + (size_t)(4 * (i0 + u) + dq) * 512);
#pragma unroll
            for (int u = 0; u < 4; ++u) { const int d = 4 * (i0 + u) + dq;
                const f32x4 q0 = *(const LAS f32x4*)(Lt + d * 16), q1 = *(const LAS f32x4*)(Lt + d * 16 + 4), k0 = *(const LAS f32x4*)(Lt + d * 16 + 8), k1 = *(const LAS f32x4*)(Lt + d * 16 + 12);
#pragma unroll
                for (int t = 0; t < 4; ++t) { oacc[t] += s[u] * q0[t]; oacc[4 + t] += s[u] * q1[t]; }
                f32x4 sn = s[u] * g8;
#pragma unroll
                for (int m = 0; m < 4; ++m) { sn += vv[m] * k0[m]; sn += vv[4 + m] * k1[m]; }
                *(f32x4*)(Sout + (size_t)d * 512) = sn; }
        }
#pragma unroll
        for (int t = 0; t < 8; ++t) *(LAS f32x4*)(Lr + (dq * 8 + t) * 512 + e) = oacc[t];
        __syncthreads();
#pragma unroll
        for (int tt = 0; tt < 2; ++tt) { const int t = 2 * dq + tt;
            f32x4 o = *(const LAS f32x4*)(Lr + (0 * 8 + t) * 512 + e) + *(const LAS f32x4*)(Lr + (1 * 8 + t) * 512 + e) + *(const LAS f32x4*)(Lr + (2 * 8 + t) * 512 + e) + *(const LAS f32x4*)(Lr + (3 * 8 + t) * 512 + e);
#pragma unroll
            for (int m = 0; m < 8; ++m) o += vv[m] * La[t * 8 + m];
            *(f32x4*)(F.O + (r0 + t) * 4096 + h * 512 + e) = o; }
    }
}

__device__ __forceinline__ void attn_prompt_phase(Frame& F, int j) {
    LAS unsigned char* L = F.lds;
    constexpr int KB_STRIDE = 144, VT_STRIDE = 528, KB_OFF = 0, VT_OFF = 256 * KB_STRIDE;
    static_assert(VT_OFF + 64 * VT_STRIDE <= RING_BYTES, "attention LDS");
    const int w = F.wave, lane = F.lane, fr = lane & 15, g = lane >> 4, tid = F.tid;
    for (int unit = F.vcu; unit < 256; unit += F.G) {
        const int qblk = unit & 15, kvh = (unit >> 4) & 3, b = unit >> 6, hq = kvh * 8 + w;
        const float sink = F.att_sinks[j * 32 + hq];
        const size_t rowb = (size_t)b * 2048; const int q0 = qblk * 128;
        __syncthreads();
#pragma unroll
        for (int i = 0; i < 4; ++i) { const int p = tid + 512 * i, kk = p >> 3, c8 = (p & 7) * 8, pos = q0 - 128 + kk;
            v4u kv = (v4u){0u, 0u, 0u, 0u}; if (pos >= 0) kv = *(const v4u*)(F.KV + (rowb + pos) * 512 + kvh * 64 + c8);
            *(LAS v4u*)(L + KB_OFF + kk * KB_STRIDE + c8 * 2) = kv; }
#pragma unroll
        for (int i = 0; i < 4; ++i) { const int p = tid + 512 * i, kk = p & 255, c8 = (p >> 8) * 8, pos = q0 - 128 + kk;
            v4u vv = (v4u){0u, 0u, 0u, 0u}; if (pos >= 0) vv = *(const v4u*)(F.KV + (rowb + pos) * 512 + 256 + kvh * 64 + c8);
#pragma unroll
            for (int q = 0; q < 4; ++q) { *(LAS unsigned short*)(L + VT_OFF + (c8 + 2 * q) * VT_STRIDE + kk * 2) = (unsigned short)(vv[q] & 0xffffu);
                                          *(LAS unsigned short*)(L + VT_OFF + (c8 + 2 * q + 1) * VT_STRIDE + kk * 2) = (unsigned short)(vv[q] >> 16); } }
        __syncthreads();
        for (int rbk = 0; rbk < 8; ++rbk) {
            const size_t qrow = rowb + q0 + 16 * rbk + fr;
            bf16x8 qf[2];
#pragma unroll
            for (int ks = 0; ks < 2; ++ks) qf[ks] = *(const bf16x8*)(F.QA + qrow * 2048 + hq * 64 + 32 * ks + 8 * g);
            f32x4 S[10]; float mx = sink;
#pragma unroll
            for (int tl = 0; tl < 9; ++tl) {
                f32x4 s = (f32x4){0.f, 0.f, 0.f, 0.f};
#pragma unroll
                for (int ks = 0; ks < 2; ++ks) { const bf16x8 kf = *(const LAS bf16x8*)(L + KB_OFF + (16 * (rbk + tl) + fr) * KB_STRIDE + (32 * ks + 8 * g) * 2);
                    s = __builtin_amdgcn_mfma_f32_16x16x32_bf16(kf, qf[ks], s, 0, 0, 0); }
#pragma unroll
                for (int i = 0; i < 4; ++i) { const int rel = 128 - 16 * tl + fr - (4 * g + i); const int kpos = q0 - 128 + 16 * (rbk + tl) + 4 * g + i;
                    const bool ok = (rel >= 0) && (rel <= 128) && (kpos >= 0);
                    s[i] = ok ? s[i] * 0.125f : -1e30f; mx = fmaxf(mx, s[i]); }
                S[tl] = s;
            }
            mx = fmaxf(mx, __shfl_xor(mx, 16)); mx = fmaxf(mx, __shfl_xor(mx, 32));
            float den = 0.f;
#pragma unroll
            for (int tl = 0; tl < 9; ++tl)
#pragma unroll
                for (int i = 0; i < 4; ++i) { const float p = __expf(S[tl][i] - mx); S[tl][i] = p; den += p; }
            S[9] = (f32x4){0.f, 0.f, 0.f, 0.f};
            den += __shfl_xor(den, 16); den += __shfl_xor(den, 32);
            den += __expf(sink - mx);
            const float rden = 1.0f / den;
            bf16* orow = F.A2 + qrow * 2048 + hq * 64 + 4 * g;
#pragma unroll
            for (int dt = 0; dt < 4; ++dt) {
                f32x4 oacc = (f32x4){0.f, 0.f, 0.f, 0.f};
#pragma unroll
                for (int tp = 0; tp < 5; ++tp) {
                    v4u pw; pw.x = cvtpk(S[2 * tp][0], S[2 * tp][1]); pw.y = cvtpk(S[2 * tp][2], S[2 * tp][3]); pw.z = cvtpk(S[2 * tp + 1][0], S[2 * tp + 1][1]); pw.w = cvtpk(S[2 * tp + 1][2], S[2 * tp + 1][3]);
                    const int k0 = 16 * (rbk + 2 * tp) + 4 * g; int k1 = k0 + 16; if (k1 > 252) k1 = 252;
                    const u32x2_t v0 = *(const LAS u32x2_t*)(L + VT_OFF + (16 * dt + fr) * VT_STRIDE + k0 * 2), v1 = *(const LAS u32x2_t*)(L + VT_OFF + (16 * dt + fr) * VT_STRIDE + k1 * 2);
                    const v4u vv = (v4u){v0.x, v0.y, v1.x, v1.y};
                    oacc = __builtin_amdgcn_mfma_f32_16x16x32_bf16(__builtin_bit_cast(bf16x8, vv), __builtin_bit_cast(bf16x8, pw), oacc, 0, 0, 0);
                }
                u32x2_t ow; ow.x = cvtpk(oacc[0] * rden, oacc[1] * rden); ow.y = cvtpk(oacc[2] * rden, oacc[3] * rden);
                *(u32x2_t*)(orow + 16 * dt) = ow;
            }
        }
    }
}

__device__ __forceinline__ void attn_sample_phase(Frame& F, int j) {
    LAS float* Kc = (LAS float*)F.lds;
    LAS float* Vc = Kc + 136 * 65;
    LAS float* Pw = Vc + 136 * 65 + F.wave * 192;
    const int w = F.wave, lane = F.lane, tid = F.tid;
    for (int unit = F.vcu; unit < 128; unit += F.G) {
        const int sb = unit >> 2, kvh = unit & 3, hq = kvh * 8 + w;
        const float sink = F.att_sinks[j * 32 + hq];
        const size_t r0 = (size_t)MP + 8 * sb;
        __syncthreads();
        for (int i = tid; i < 136 * 64; i += 512) { const int kk = i >> 6, d = i & 63; float kv, vv;
            if (kk < 128) { kv = F.cache_k[((size_t)(sb * 128 + kk) * 4 + kvh) * 64 + d]; vv = F.cache_v[((size_t)(sb * 128 + kk) * 4 + kvh) * 64 + d]; }
            else { kv = bf2f(F.KV[(r0 + kk - 128) * 512 + kvh * 64 + d]); vv = bf2f(F.KV[(r0 + kk - 128) * 512 + 256 + kvh * 64 + d]); }
            Kc[kk * 65 + d] = kv; Vc[kk * 65 + d] = vv; }
        __syncthreads();
        for (int t = 0; t < 8; ++t) {
            const float qv = bf2f(F.QA[(r0 + t) * 2048 + hq * 64 + lane]);
            float s0 = 0.f, s1 = 0.f, s2 = 0.f; const int k2 = (lane < 8) ? 128 + lane : 135;
            for (int d = 0; d < 64; ++d) { const float qd = __shfl(qv, d); s0 += qd * Kc[lane * 65 + d]; s1 += qd * Kc[(64 + lane) * 65 + d]; s2 += qd * Kc[k2 * 65 + d]; }
            const bool ok0 = lane >= t, ok1 = true, ok2 = (lane < 8) && (lane <= t);
            s0 = ok0 ? s0 * 0.125f : -1e30f; s1 = ok1 ? s1 * 0.125f : -1e30f; s2 = ok2 ? s2 * 0.125f : -1e30f;
            float mx = fmaxf(fmaxf(s0, s1), fmaxf(s2, sink));
#pragma unroll
            for (int o = 1; o < 64; o <<= 1) mx = fmaxf(mx, __shfl_xor(mx, o));
            const float p0 = __expf(s0 - mx), p1 = __expf(s1 - mx), p2 = (lane < 8) ? __expf(s2 - mx) : 0.f;
            const float den = wave_sum(p0 + p1 + p2) + __expf(sink - mx);
            Pw[lane] = p0; Pw[64 + lane] = p1; if (lane < 8) Pw[128 + lane] = p2;
            LDS_WAIT(); asm volatile("" ::: "memory");
            float o = 0.f;
            for (int kk = 0; kk < 136; ++kk) o += Pw[kk] * Vc[kk * 65 + lane];
            F.A2[(r0 + t) * 2048 + hq * 64 + lane] = (bf16)(cvtpk(o / den, 0.f) & 0xffffu);
            LDS_WAIT(); asm volatile("" ::: "memory");
        }
    }
}

#ifndef MK_MULTI
#define MK_MULTI 1
#endif
constexpr int N_PHASES = 36;

__device__ __forceinline__ void frame_refresh(Frame& F) {
    extern __shared__ __attribute__((aligned(16))) unsigned char lds[];
    int t_ = threadIdx.x; asm volatile("" : "+v"(t_));
    F.tid = t_; F.lane = t_ & 63; F.wave = __builtin_amdgcn_readfirstlane(t_ >> 6);
    F.lds = (LAS unsigned char*)lds;
    F.MISC = (volatile LAS unsigned*)(F.lds + MISC_OFF);
    const __attribute__((address_space(4))) unsigned char* ka = (const __attribute__((address_space(4))) unsigned char*)__builtin_amdgcn_kernarg_segment_ptr();
    asm volatile("" : "+s"(ka));
#define KIN(k) (*(const float* const __attribute__((address_space(4)))*)(ka + 8 * (k)))
    F.x_prompt = KIN(0); F.x_sample = KIN(1); F.state_ret = KIN(2); F.cache_k = KIN(3); F.cache_v = KIN(4); F.state_conv = KIN(5); F.c_prompt = KIN(6); F.c_sample = KIN(7);
    F.w_ada = KIN(8); F.b_ada = KIN(9); F.norm_mix = KIN(10); F.norm_ffn = KIN(11); F.ret_w_in = KIN(12); F.ret_gn = KIN(13); F.ret_w_out = KIN(14);
    F.kv_norm = KIN(15); F.kv_w_ada = KIN(16); F.kv_b_ada = KIN(17); F.w_kv = KIN(18); F.att_w_q = KIN(19); F.att_sinks = KIN(20); F.att_w_o = KIN(21);
    F.ffn_w_up = KIN(22); F.ffn_conv_w = KIN(23); F.ffn_conv_b = KIN(24); F.ffn_w_down = KIN(25); F.norm_f = KIN(26);
    F.out = (float*)KIN(27);
    unsigned char* ws = (unsigned char*)KIN(28);
#undef KIN
    F.ctl = (gu32*)(ws + WS_CTL);
    F.mods = (float*)(ws + WS_MODS); F.kvmods = (float*)(ws + WS_KVMODS); F.rtr = (float*)(ws + WS_RTR); F.rta = (float*)(ws + WS_RTA); F.X = (float*)(ws + WS_X); F.O = (float*)(ws + WS_O);
    F.H = (bf16*)(ws + WS_H); F.HK = (bf16*)(ws + WS_HK); F.QKVG = (bf16*)(ws + WS_QKVG); F.U = (bf16*)(ws + WS_U); F.A2 = (bf16*)(ws + WS_A2); F.QA = (bf16*)(ws + WS_QA); F.KV = (bf16*)(ws + WS_KV);
    F.WIN = (bf16*)(ws + WS_WIN); F.WOUT = (bf16*)(ws + WS_WOUT); F.WUP = (bf16*)(ws + WS_WUP); F.WDOWN = (bf16*)(ws + WS_WDOWN); F.WQ = (bf16*)(ws + WS_WQ); F.WO = (bf16*)(ws + WS_WO); F.WKV = (bf16*)(ws + WS_WKV);
}
struct Args { const float* in[27]; float* out; unsigned char* ws; int ph_lo, ph_hi, use_bar, pad; };
__global__ void __launch_bounds__(NWAVES * 64, 2) yoco_fwd(Args args) {
    extern __shared__ __attribute__((aligned(16))) unsigned char lds[];
    Frame F;
    F.G = gridDim.x; { const int bx = blockIdx.x; F.vcu = (F.G % 8 == 0) ? (bx % 8) * (F.G / 8) + bx / 8 : bx; }
    frame_refresh(F);
    for (int u = F.tid; u < (LDS_BYTES - LDSCTL_OFF) / 4; u += NWAVES * 64) ((LAS unsigned*)(F.lds + LDSCTL_OFF))[u] = 0u;
    __syncthreads();
    XcdBarrier bar; bar.bar = (unsigned*)(args.ws + WS_CTL) + CW_BAR; bar.x = 0; bar.st = (volatile LAS unsigned*)(F.lds + MISC_OFF) + 8;
    if (args.use_bar) bar = xcd_barrier_post(bar.bar, bar.st);
    const int lo = args.ph_lo, hi = args.ph_hi;
    int ph = 0;
#ifndef EN_MASK
#define EN_MASK 0xffffffffu
#endif
#define EN(k) ((EN_MASK >> (k)) & 1u)
#define PH_ON ((ph >= lo && ph < hi) && (frame_refresh(F), true))
#define PH_END do { if (ph >= lo && ph + 1 < hi) xcd_barrier(bar); ++ph; } while (0)

    if (PH_ON && EN(0)) { p0_mods(F); frame_refresh(F); p0_weights(F); frame_refresh(F); p0_tables(F); frame_refresh(F); p0_copies(F); }
    PH_END;

    for (int l = 0; l < 4; ++l) {
        #define md (F.mods + (size_t)l * NBM * NMOD)
        if (PH_ON && EN(1)) {
            if (l == 2) t_norm_mod(F, F.norm_mix + l * D, md, md + D, NMOD, F.H, F.kv_norm, F.kvmods, F.kvmods + D, 4096, F.HK);
            else        t_norm_mod(F, F.norm_mix + l * D, md, md + D, NMOD, F.H, nullptr, nullptr, nullptr, 0, nullptr);
        }
        PH_END;
        if (l < 2) {
            if (PH_ON && EN(2)) { pg8::Gemm g{F.H, F.WIN + (size_t)l * NQKVG * D, MT, NQKVG, D}; pg8::StaticOrder S; S.init(MT, NQKVG, F.G, (int)blockIdx.x);
                pg8::EpiRetIn E{F.QKVG, F.rtr};
                pg8::gemm_phase<pg8::EpiRetIn, pg8::StaticOrder, true, true>(F.lds, g, S, E); }
            PH_END;
            if (PH_ON) { if (EN(3)) ret_prompt_phase(F, l); if (EN(4)) ret_sample_phase(F, l); }
            PH_END;
            if (PH_ON && EN(5)) t_gn_gate(F, l);
            PH_END;
        } else {
            const int j = l - 2;
            if (PH_ON && EN(6)) {
                { pg8::Gemm g{F.H, F.WQ + (size_t)j * D * D, MT, D, D}; pg8::StaticOrder S; S.init(MT, D, F.G, (int)blockIdx.x);
                  pg8::EpiHead E{F.QA, D, F.rta, 8, nullptr, nullptr, nullptr, nullptr};
                  pg8::gemm_phase<pg8::EpiHead, pg8::StaticOrder, true, true>(F.lds, g, S, E); }
                if (l == 2) { pg8::Gemm g{F.HK, F.WKV, MT, 512, D}; pg8::StaticOrder S; S.init(MT, 512, F.G, (int)blockIdx.x);
                  pg8::EpiHead E{F.KV, 512, F.rta, 1, F.out + O_WKP, F.out + O_WVP, F.out + O_WKS, F.out + O_WVS};
                  pg8::gemm_phase<pg8::EpiHead, pg8::StaticOrder, true, true>(F.lds, g, S, E); }
            }
            PH_END;
            if (PH_ON) { if (EN(7)) attn_prompt_phase(F, j); if (EN(8)) attn_sample_phase(F, j); }
            PH_END;
        }
        if (PH_ON && EN(9)) {
            const bf16* Bt = (l < 2) ? F.WOUT + (size_t)l * D * 4096 : F.WO + (size_t)(l - 2) * D * D; const int K = (l < 2) ? 4096 : D;
            pg8::Gemm g{F.A2, Bt, MT, D, K}; pg8::StaticOrder S; S.init(MT, D, F.G, (int)blockIdx.x);
            pg8::EpiResid E{F.X, md + 2 * D};
            pg8::gemm_phase<pg8::EpiResid, pg8::StaticOrder, true, true>(F.lds, g, S, E);
        }
        PH_END;
        if (PH_ON && EN(10)) t_norm_mod(F, F.norm_ffn + l * D, md + 3 * D, md + 4 * D, NMOD, F.H, nullptr, nullptr, nullptr, 0, nullptr);
        PH_END;
        if (PH_ON && EN(11)) { pg8::Gemm g{F.H, F.WUP + (size_t)l * FF2 * D, MT, FF2, D}; pg8::StaticOrder S; S.init(MT, FF2, F.G, (int)blockIdx.x);
            pg8::EpiPlain E{F.U, FF2};
            pg8::gemm_phase<pg8::EpiPlain, pg8::StaticOrder, true, true>(F.lds, g, S, E); }
        PH_END;
        if (PH_ON && EN(12)) t_conv_gate(F, l);
        PH_END;
        if (PH_ON && EN(13)) { pg8::Gemm g{F.A2, F.WDOWN + (size_t)l * D * DFF, MT, D, DFF}; pg8::StaticOrder S; S.init(MT, D, F.G, (int)blockIdx.x);
            pg8::EpiResid E{F.X, md + 5 * D};
            pg8::gemm_phase<pg8::EpiResid, pg8::StaticOrder, true, true>(F.lds, g, S, E); }
        PH_END;
    }
    if (PH_ON && EN(14)) t_final_norm(F);
#undef md
#undef PH_ON
#undef PH_END
}

extern "C" void kernel_launch(void* const* d_in, const int* in_sizes, int n_in, void* d_out, int out_size, void* d_ws, size_t ws_size, hipStream_t stream) {
    static int grid = 0;
    if (grid == 0) {
        if (n_in != 27 || (size_t)out_size != O_TOTAL || ws_size < WS_END) { fprintf(stderr, "kernel_launch: unexpected problem: n_in %d out %d ws %zu (need 27, %zu, >= %zu); nothing launched\n", n_in, out_size, ws_size, (size_t)O_TOTAL, (size_t)WS_END); grid = -1; return; }
        int dev = 0, cus = 0, per_cu = 0;
        if (hipGetDevice(&dev) != hipSuccess || hipDeviceGetAttribute(&cus, hipDeviceAttributeMultiprocessorCount, dev) != hipSuccess) { fprintf(stderr, "kernel_launch: device query failed\n"); grid = -1; return; }
        if (hipFuncSetAttribute((const void*)yoco_fwd, hipFuncAttributeMaxDynamicSharedMemorySize, LDS_BYTES) != hipSuccess) { fprintf(stderr, "kernel_launch: hipFuncSetAttribute failed\n"); grid = -1; return; }
        if (hipOccupancyMaxActiveBlocksPerMultiprocessor(&per_cu, (const void*)yoco_fwd, NWAVES * 64, LDS_BYTES) != hipSuccess || per_cu < 1)
            fprintf(stderr, "kernel_launch: note: occupancy query reports %d workgroups per CU\n", per_cu);
        (void)hipGetLastError();
        grid = cus;
    }
    if (grid < 0) return;
    if (hipMemsetAsync((char*)d_ws + WS_CTL, 0, ZERO_BYTES, stream) != hipSuccess) { fprintf(stderr, "kernel_launch: hipMemsetAsync failed\n"); return; }
    Args a{};
    for (int i = 0; i < 27; ++i) a.in[i] = (const float*)d_in[i];
    a.out = (float*)d_out; a.ws = (unsigned char*)d_ws; a.pad = 0;
#if MK_MULTI
    for (int p = 0; p < N_PHASES; ++p) { a.ph_lo = p; a.ph_hi = p + 1; a.use_bar = 0;
        hipLaunchKernelGGL(yoco_fwd, dim3(grid), dim3(NWAVES * 64), LDS_BYTES, stream, a); }
#else
    a.ph_lo = 0; a.ph_hi = N_PHASES; a.use_bar = 1;
    hipLaunchKernelGGL(yoco_fwd, dim3(grid), dim3(NWAVES * 64), LDS_BYTES, stream, a);
#endif
    const hipError_t le = hipPeekAtLastError();
    if (le != hipSuccess) fprintf(stderr, "kernel_launch: launch failed: %s\n", hipGetErrorName(le));
}
```

```cpp
#include <hip/hip_runtime.h>
#include <cstdio>
#include <cstdint>
namespace pg8 {
#define PG8_LAS __attribute__((address_space(3)))
typedef unsigned short bf16_t;
typedef short bf16x8 __attribute__((ext_vector_type(8)));
typedef float f32x4 __attribute__((ext_vector_type(4)));
typedef unsigned u32x4 __attribute__((ext_vector_type(4)));
constexpr int BM = 256, BK = 64, HALF = 128, HTB = HALF * BK * 2  , STAGE_BYTES = 8 * HTB, NXCD = 8, WGM = 8;

__host__ __device__ __forceinline__ int lds_byte(int r, int c) { const int st = (r >> 4) * 2 + (c >> 5), rr = r & 15, cc = c & 31, ob = rr * 64 + cc * 2; return st * 1024 + (ob ^ (((ob >> 9) & 1) << 5)); }
__host__ __device__ __forceinline__ void stage_rc(int b, int& R, int& C) { const int st = b / 1024, sb = b % 1024, swz = sb ^ (((sb >> 9) & 1) << 5); R = (st >> 1) * 16 + swz / 64; C = (st & 1) * 32 + (swz % 64) / 2; }
__host__ __device__ __forceinline__ int perm32(int rho) { const int n = rho >> 4, i = rho & 15; return 8 * (i >> 2) + 4 * n + (i & 3); }

struct Unit { int pm, pn; };
struct Gemm { const bf16_t* A; const bf16_t* Bt; int M, N, K; };

struct StaticOrder {
    int nM, nN, nwg, G, c;
    __host__ __device__ void init(int M, int N, int G_, int c_) { nM = M / BM; nN = N / BM; nwg = nM * nN; G = G_; c = c_; }
    __host__ __device__ bool next(int i, Unit& u) const {
        const long L = (long)i * G + c; if (L >= nwg) return false;
        int wgid = (int)L; { const int q = nwg / NXCD, r = nwg % NXCD, xcd = wgid % NXCD, off = wgid / NXCD; wgid = (xcd < r ? xcd * (q + 1) : r * (q + 1) + (xcd - r) * q) + off; }
        const int nig = WGM * nN, gid = wgid / nig, fm = gid * WGM, gsz = (nM - fm) < WGM ? (nM - fm) : WGM;
        u.pm = fm + ((wgid % nig) % gsz); u.pn = (wgid % nig) / gsz; return true;
    }
    __device__ __forceinline__ void a_ready(const Unit&) const {}
    __device__ __forceinline__ void done(const Unit&) const {}
};

__device__ __forceinline__ unsigned cvt_pk_bf16(float lo, float hi) { unsigned r; asm volatile("v_cvt_pk_bf16_f32 %0, %1, %2" : "=v"(r) : "v"(lo), "v"(hi)); return r; }
typedef float f32x2 __attribute__((ext_vector_type(2)));
__device__ __forceinline__ int bidx_of(int row) { return row < 8192 ? (row >> 11) : 4 + ((row - 8192) >> 3); }
__device__ __forceinline__ int pidx_of(int row) { return row < 8192 ? (row & 2047) : 2048 + (row & 7); }
__device__ __forceinline__ float silu_f(float x) { return x * __builtin_amdgcn_rcpf(1.0f + __builtin_amdgcn_exp2f(-1.4426950408889634f * x)); }
__device__ __forceinline__ u32x4 pack8(const f32x4 a, const f32x4 b) { u32x4 w; w.x = cvt_pk_bf16(a[0], a[1]); w.y = cvt_pk_bf16(a[2], a[3]); w.z = cvt_pk_bf16(b[0], b[1]); w.w = cvt_pk_bf16(b[2], b[3]); return w; }

struct EpiPlain {
    static constexpr bool PERM = true, AFTER_DRAIN = false;
    bf16_t* O; int ldc;
    __device__ __forceinline__ void operator()(const f32x4 (&acc)[2][2][4][2], const Unit& u, int wr, int wc, int fr, int fq) const {
        const int row0 = u.pm * BM + wr * 64 + fr, col0 = u.pn * BM + wc * 32 + 8 * fq;
#pragma unroll
        for (int ai = 0; ai < 2; ++ai)
#pragma unroll
            for (int m = 0; m < 4; ++m) { bf16_t* rowp = O + (size_t)(row0 + ai * HALF + m * 16) * ldc + col0;
#pragma unroll
                for (int bj = 0; bj < 2; ++bj) *(u32x4*)(rowp + bj * HALF) = pack8(acc[ai][bj][m][0], acc[ai][bj][m][1]); }
    }
};

struct EpiRetIn {
    static constexpr bool PERM = true, AFTER_DRAIN = false;
    bf16_t* O; const float* rt;
    __device__ __forceinline__ void operator()(const f32x4 (&acc)[2][2][4][2], const Unit& u, int wr, int wc, int fr, int fq) const {
        const int row0 = u.pm * BM + wr * 64 + fr, col0 = u.pn * BM + wc * 32 + 8 * fq;
        const int kind = u.pn < 16 ? 0 : (u.pn < 32 ? 1 : 2);
        const float ksc = (u.pn >= 8) ? 0.0625f : 1.0f;
#pragma unroll
        for (int ai = 0; ai < 2; ++ai)
#pragma unroll
            for (int m = 0; m < 4; ++m) {
                const int row = row0 + ai * HALF + m * 16; bf16_t* rowp = O + (size_t)row * 12288 + col0;
                f32x4 a0 = acc[ai][0][m][0], a1 = acc[ai][0][m][1], b0 = acc[ai][1][m][0], b1 = acc[ai][1][m][1];
                if (kind == 0) {
                    const float* tp = rt + ((size_t)pidx_of(row) * 128 + wc * 32 + 8 * fq) * 2;
                    const f32x4 t0 = *(const f32x4*)(tp), t1 = *(const f32x4*)(tp + 4), t2 = *(const f32x4*)(tp + 8), t3 = *(const f32x4*)(tp + 12);
                    f32x4 ra0, ra1, rb0, rb1;
                    ra0[0] = a0[0] * t0[0] - b0[0] * t0[1]; rb0[0] = b0[0] * t0[0] + a0[0] * t0[1];
                    ra0[1] = a0[1] * t0[2] - b0[1] * t0[3]; rb0[1] = b0[1] * t0[2] + a0[1] * t0[3];
                    ra0[2] = a0[2] * t1[0] - b0[2] * t1[1]; rb0[2] = b0[2] * t1[0] + a0[2] * t1[1];
                    ra0[3] = a0[3] * t1[2] - b0[3] * t1[3]; rb0[3] = b0[3] * t1[2] + a0[3] * t1[3];
                    ra1[0] = a1[0] * t2[0] - b1[0] * t2[1]; rb1[0] = b1[0] * t2[0] + a1[0] * t2[1];
                    ra1[1] = a1[1] * t2[2] - b1[1] * t2[3]; rb1[1] = b1[1] * t2[2] + a1[1] * t2[3];
                    ra1[2] = a1[2] * t3[0] - b1[2] * t3[1]; rb1[2] = b1[2] * t3[0] + a1[2] * t3[1];
                    ra1[3] = a1[3] * t3[2] - b1[3] * t3[3]; rb1[3] = b1[3] * t3[2] + a1[3] * t3[3];
                    a0 = ra0 * ksc; a1 = ra1 * ksc; b0 = rb0 * ksc; b1 = rb1 * ksc;
                } else if (kind == 2) {
#pragma unroll
                    for (int e = 0; e < 4; ++e) { a0[e] = silu_f(a0[e]); a1[e] = silu_f(a1[e]); b0[e] = silu_f(b0[e]); b1[e] = silu_f(b1[e]); }
                }
                *(u32x4*)(rowp) = pack8(a0, a1); *(u32x4*)(rowp + HALF) = pack8(b0, b1);
                if (m & 1) asm volatile("" ::: "memory");
            }
    }
};

struct EpiResid {
    static constexpr bool PERM = false, AFTER_DRAIN = false;
    float* X; const float* gate;
    __device__ __forceinline__ void operator()(const f32x4 (&acc)[2][2][4][2], const Unit& u, int wr, int wc, int fr, int fq) const {
        const int row0 = u.pm * BM + wr * 64 + fr, col0 = u.pn * BM + wc * 32 + 4 * fq;
#pragma unroll
        for (int ai = 0; ai < 2; ++ai)
#pragma unroll
            for (int m = 0; m < 4; ++m) {
                const int row = row0 + ai * HALF + m * 16; float* xr = X + (size_t)row * 2048 + col0; const float* gr = gate + (size_t)bidx_of(row) * 12288 + col0;
#pragma unroll
                for (int bj = 0; bj < 2; ++bj)
#pragma unroll
                    for (int n = 0; n < 2; ++n) { const f32x4 g4 = *(const f32x4*)(gr + bj * HALF + n * 16); f32x4 x4 = *(const f32x4*)(xr + bj * HALF + n * 16);
                        x4 = x4 + g4 * acc[ai][bj][m][n]; *(f32x4*)(xr + bj * HALF + n * 16) = x4; }
                if (m & 1) asm volatile("" ::: "memory");
            }
    }
};

struct EpiHead {
    static constexpr bool PERM = true, AFTER_DRAIN = false;
    bf16_t* O; int ldc; const float* rta;
    int rope_tiles;
    float* wk_p; float* wv_p; float* wk_s; float* wv_s;
    __device__ __forceinline__ void operator()(const f32x4 (&acc)[2][2][4][2], const Unit& u, int wr, int wc, int fr, int fq) const {
        const int row0 = u.pm * BM + wr * 64 + fr, col0 = u.pn * BM + wc * 32 + 8 * fq;
        const bool rope = (u.pn < rope_tiles) && ((wc & 1) == 0);
#pragma unroll
        for (int ai = 0; ai < 2; ++ai)
#pragma unroll
            for (int m = 0; m < 4; ++m) {
                const int row = row0 + ai * HALF + m * 16; bf16_t* rowp = O + (size_t)row * ldc + col0;
#pragma unroll
                for (int bj = 0; bj < 2; ++bj) {
                    f32x4 v0 = acc[ai][bj][m][0], v1 = acc[ai][bj][m][1];
                    if (rope) {
                        f32x4 p0, p1;
#pragma unroll
                        for (int e = 0; e < 4; ++e) { p0[e] = __shfl_xor(v0[e], 16); p1[e] = __shfl_xor(v1[e], 16); }
                        if (fq < 2) {
                            const float* tp = rta + (size_t)pidx_of(row) * 16;
                            const f32x4 t0 = *(const f32x4*)(tp), t1 = *(const f32x4*)(tp + 4), t2 = *(const f32x4*)(tp + 8), t3 = *(const f32x4*)(tp + 12);
                            const float sg = (fq == 0) ? -1.0f : 1.0f;
                            v0[0] = v0[0] * t0[0] + sg * p0[0] * t0[1]; v0[1] = v0[1] * t0[2] + sg * p0[1] * t0[3];
                            v0[2] = v0[2] * t1[0] + sg * p0[2] * t1[1]; v0[3] = v0[3] * t1[2] + sg * p0[3] * t1[3];
                            v1[0] = v1[0] * t2[0] + sg * p1[0] * t2[1]; v1[1] = v1[1] * t2[2] + sg * p1[1] * t2[3];
                            v1[2] = v1[2] * t3[0] + sg * p1[2] * t3[1]; v1[3] = v1[3] * t3[2] + sg * p1[3] * t3[3];
                        }
                    }
                    *(u32x4*)(rowp + bj * HALF) = pack8(v0, v1);
                    if (wk_p) {
                        const int c = wc * 32 + 8 * fq + bj * HALF; float* dst = nullptr;
                        if (row < 8192) { const int t = row & 2047; if (t >= 1920) dst = (u.pn == 0 ? wk_p : wv_p) + ((size_t)(row >> 11) * 128 + (t - 1920)) * 256 + c; }
                        else { const int sb = (row - 8192) >> 3, t = row & 7; dst = (u.pn == 0 ? wk_s : wv_s) + ((size_t)sb * 128 + 120 + t) * 256 + c; }
                        if (dst) { *(f32x4*)(dst) = v0; *(f32x4*)(dst + 4) = v1; }
                    }
                }
                if (m & 1) asm volatile("" ::: "memory");
            }
    }
};
template <class Epi, class Sched, bool ALIGN_EPI = false, bool SP2 = false>
__device__ __forceinline__ void gemm_phase(PG8_LAS unsigned char* lds, const Gemm g, const Sched& S, const Epi& E) {
    int tid_ = threadIdx.x; asm volatile("" : "+v"(tid_));
    const int tid = tid_, wid = __builtin_amdgcn_readfirstlane(tid >> 6), lane = tid & 63, wr = wid >> 2, wc = wid & 3, fr = lane & 15, fq = lane >> 4;
    const int K = g.K, nt = K / BK;
    unsigned voffA[2], voffB[2];
#pragma unroll
    for (int i = 0; i < 2; ++i) { int R, C; stage_rc(tid * 16 + i * 8192, R, C); const int Rb = Epi::PERM ? ((R & ~31) + perm32(R & 31)) : R;
        voffA[i] = (unsigned)(R * K + C) * 2u; voffB[i] = (unsigned)(Rb * K + C) * 2u; }
    const size_t kstep = (size_t)(BK * 2);
    const size_t hstep = (size_t)HALF * K * 2;
    const size_t tstep = 2 * hstep;
    const unsigned ldsw = (unsigned)wid * 1024u;
    const int aoff = lds_byte(wr * 64 + fr, fq * 8), boff = lds_byte(wc * 32 + fr, fq * 8);
#define PG8_SA(b, h) (((b) * 2 + (h)) * HTB)
#define PG8_SB(b, h) ((4 + (b) * 2 + (h)) * HTB)
#define PG8_STAGE(bufoff, gbase, voff) do { _Pragma("unroll") for (int _i = 0; _i < 2; ++_i) \
        __builtin_amdgcn_global_load_lds((const unsigned*)((const char*)(gbase) + (voff)[_i]), (PG8_LAS unsigned*)(lds + (bufoff) + ldsw + _i * 8192), 16, 0, 0); } while (0)
#define PG8_LDA(dst, b, h) do { _Pragma("unroll") for (int m = 0; m < 4; ++m) _Pragma("unroll") for (int k = 0; k < 2; ++k) dst[m][k] = *(const PG8_LAS bf16x8*)(lds + PG8_SA(b, h) + aoff + m * 2048 + k * 1024); } while (0)
#define PG8_LDB(dst, b, h) do { _Pragma("unroll") for (int n = 0; n < 2; ++n) _Pragma("unroll") for (int k = 0; k < 2; ++k) dst[n][k] = *(const PG8_LAS bf16x8*)(lds + PG8_SB(b, h) + boff + n * 2048 + k * 1024); } while (0)
#define PG8_MMA(ai, bj, At, Bt) do { __builtin_amdgcn_s_setprio(1); _Pragma("unroll") for (int m = 0; m < 4; ++m) _Pragma("unroll") for (int n = 0; n < 2; ++n) _Pragma("unroll") for (int k = 0; k < 2; ++k) \
        acc[ai][bj][m][n] = __builtin_amdgcn_mfma_f32_16x16x32_bf16(Bt[n][k], At[m][k], acc[ai][bj][m][n], 0, 0, 0); __builtin_amdgcn_s_setprio(0); } while (0)
#define PG8_WAIT_V(n) asm volatile("s_waitcnt vmcnt(" #n ")" ::: "memory")
#define PG8_WAIT_L(n) asm volatile("s_waitcnt lgkmcnt(" #n ")" ::: "memory")
#define PG8_BAR __builtin_amdgcn_s_barrier()
#define PG8_SCHED __builtin_amdgcn_sched_barrier(0)
    Unit cur, nxt; int ui = 0;
    if (!S.next(0, cur)) return;
    f32x4 acc[2][2][4][2];
#pragma unroll
    for (int a = 0; a < 2; ++a)
#pragma unroll
        for (int b = 0; b < 2; ++b)
#pragma unroll
            for (int m = 0; m < 4; ++m)
#pragma unroll
                for (int n = 0; n < 2; ++n) acc[a][b][m][n] = (f32x4){0.f, 0.f, 0.f, 0.f};
    bf16x8 At[4][2], B0[2][2], B1[2][2];
    const char* cA = (const char*)g.A + (size_t)cur.pm * tstep; const char* cB = (const char*)g.Bt + (size_t)cur.pn * tstep;
    S.a_ready(cur);
    if constexpr (SP2) {
        PG8_STAGE(PG8_SB(0, 0), cB, voffB); PG8_STAGE(PG8_SB(0, 1), cB + hstep, voffB); PG8_STAGE(PG8_SA(0, 0), cA, voffA); PG8_STAGE(PG8_SA(0, 1), cA + hstep, voffA);
        if (wr == 1) PG8_BAR;
        PG8_WAIT_V(2); PG8_BAR;
        PG8_STAGE(PG8_SB(1, 0), cB + kstep, voffB); PG8_STAGE(PG8_SA(1, 0), cA + kstep, voffA); PG8_STAGE(PG8_SB(1, 1), cB + hstep + kstep, voffB);
        PG8_WAIT_V(6); PG8_BAR;
    } else {
        PG8_STAGE(PG8_SB(0, 0), cB, voffB); PG8_STAGE(PG8_SA(0, 0), cA, voffA); PG8_STAGE(PG8_SB(0, 1), cB + hstep, voffB); PG8_STAGE(PG8_SA(0, 1), cA + hstep, voffA);
        if (wr == 1) PG8_BAR;
        PG8_WAIT_V(4); PG8_BAR;
        PG8_STAGE(PG8_SB(1, 0), cB + kstep, voffB); PG8_STAGE(PG8_SA(1, 0), cA + kstep, voffA); PG8_STAGE(PG8_SB(1, 1), cB + hstep + kstep, voffB);
        PG8_WAIT_V(6); PG8_BAR;
    }
    for (;;) {
        const bool has_next = S.next(ui + 1, nxt);
        const char* nA = has_next ? (const char*)g.A + (size_t)nxt.pm * tstep : cA; const char* nB = has_next ? (const char*)g.Bt + (size_t)nxt.pn * tstep : cB;
        for (int t = 0; t < nt; t += 2) {
            const bool last = (t == nt - 2);
            const char* a1 = cA + (size_t)(t + 1) * kstep;
            const char* a2 = last ? nA : cA + (size_t)(t + 2) * kstep; const char* b2 = last ? nB : cB + (size_t)(t + 2) * kstep;
            const char* a3 = a2 + kstep; const char* b3 = b2 + kstep;
            if (last && has_next) S.a_ready(nxt);
            if constexpr (SP2) {
            PG8_LDB(B0, 0, 0); PG8_LDB(B1, 0, 1); PG8_SCHED; PG8_LDA(At, 0, 0); PG8_STAGE(PG8_SA(1, 1), a1 + hstep, voffA);
            PG8_WAIT_V(8); PG8_WAIT_L(0); PG8_BAR; PG8_MMA(0, 0, At, B0); PG8_MMA(0, 1, At, B1); PG8_BAR; PG8_SCHED;
            PG8_LDA(At, 0, 1); PG8_STAGE(PG8_SB(0, 0), b2, voffB); PG8_STAGE(PG8_SB(0, 1), b2 + hstep, voffB); PG8_STAGE(PG8_SA(0, 0), a2, voffA);
            PG8_WAIT_V(8); PG8_WAIT_L(0); PG8_BAR; PG8_MMA(1, 0, At, B0); PG8_MMA(1, 1, At, B1); PG8_BAR; PG8_SCHED;
            PG8_LDB(B0, 1, 0); PG8_LDB(B1, 1, 1); PG8_SCHED; PG8_LDA(At, 1, 0); PG8_STAGE(PG8_SA(0, 1), a2 + hstep, voffA);
            PG8_WAIT_V(8); PG8_WAIT_L(0); PG8_BAR; PG8_MMA(0, 0, At, B0); PG8_MMA(0, 1, At, B1); PG8_BAR; PG8_SCHED;
            PG8_LDA(At, 1, 1); PG8_STAGE(PG8_SB(1, 0), b3, voffB); PG8_STAGE(PG8_SB(1, 1), b3 + hstep, voffB); PG8_STAGE(PG8_SA(1, 0), a3, voffA);
            PG8_WAIT_V(8); PG8_WAIT_L(0); PG8_BAR; PG8_MMA(1, 0, At, B0); PG8_MMA(1, 1, At, B1); PG8_BAR; PG8_SCHED;
            } else {
            PG8_LDB(B0, 0, 0); PG8_SCHED; PG8_LDA(At, 0, 0); PG8_STAGE(PG8_SA(1, 1), a1 + hstep, voffA);
            PG8_WAIT_L(8); PG8_BAR; PG8_WAIT_L(0); PG8_MMA(0, 0, At, B0); PG8_BAR; PG8_SCHED;
            PG8_LDB(B1, 0, 1); PG8_STAGE(PG8_SB(0, 0), b2, voffB);
            PG8_BAR; PG8_WAIT_L(0); PG8_MMA(0, 1, At, B1); PG8_BAR;
            PG8_LDA(At, 0, 1); PG8_STAGE(PG8_SA(0, 0), a2, voffA);
            PG8_BAR; PG8_WAIT_L(0); PG8_MMA(1, 0, At, B0); PG8_BAR; PG8_SCHED;
            PG8_STAGE(PG8_SB(0, 1), b2 + hstep, voffB);
            PG8_WAIT_V(6); PG8_BAR; PG8_MMA(1, 1, At, B1); PG8_BAR;
            PG8_LDB(B0, 1, 0); PG8_SCHED; PG8_LDA(At, 1, 0); PG8_STAGE(PG8_SA(0, 1), a2 + hstep, voffA);
            PG8_WAIT_L(8); PG8_BAR; PG8_WAIT_L(0); PG8_MMA(0, 0, At, B0); PG8_BAR; PG8_SCHED;
            PG8_LDB(B1, 1, 1); PG8_STAGE(PG8_SB(1, 0), b3, voffB);
            PG8_BAR; PG8_WAIT_L(0); PG8_MMA(0, 1, At, B1); PG8_BAR;
            PG8_LDA(At, 1, 1); PG8_STAGE(PG8_SA(1, 0), a3, voffA);
            PG8_BAR; PG8_WAIT_L(0); PG8_MMA(1, 0, At, B0); PG8_BAR; PG8_SCHED;
            PG8_STAGE(PG8_SB(1, 1), b3 + hstep, voffB);
            PG8_WAIT_V(6); PG8_BAR; PG8_MMA(1, 1, At, B1); PG8_BAR;
            }
        }
        if constexpr (ALIGN_EPI) { if (wr == 0) PG8_BAR; }
        if constexpr (!Epi::AFTER_DRAIN) { E(acc, cur, wr, wc, fr, fq); S.done(cur); }
        if (!has_next) break;
#pragma unroll
        for (int a = 0; a < 2; ++a)
#pragma unroll
            for (int b = 0; b < 2; ++b)
#pragma unroll
                for (int m = 0; m < 4; ++m)
#pragma unroll
                    for (int n = 0; n < 2; ++n) acc[a][b][m][n] = (f32x4){0.f, 0.f, 0.f, 0.f};
        cur = nxt; cA = nA; cB = nB; ++ui;
        if constexpr (ALIGN_EPI) { if (wr == 1) PG8_BAR; }
    }
    PG8_WAIT_V(0);
    if constexpr (!ALIGN_EPI) { if (wr == 0) PG8_BAR; }
    PG8_BAR;
    if constexpr (Epi::AFTER_DRAIN) { E.fused(acc, cur, wr, wc, fr, fq, lds, wid, lane); S.done(cur); }
#undef PG8_SA
#undef PG8_SB
#undef PG8_STAGE
#undef PG8_LDA
#undef PG8_LDB
#undef PG8_MMA
#undef PG8_WAIT_V
#undef PG8_WAIT_L
#undef PG8_BAR
#undef PG8_SCHED
}
}
#define GAS __attribute__((address_space(1)))
#define LAS __attribute__((address_space(3)))
typedef unsigned short bf16;
typedef unsigned v4u __attribute__((ext_vector_type(4)));
typedef float f32x4 __attribute__((ext_vector_type(4)));
typedef short bf16x8 __attribute__((ext_vector_type(8)));
typedef GAS unsigned gu32;
typedef GAS unsigned long long gu64;
#define RLX_AGENT __ATOMIC_RELAXED, __HIP_MEMORY_SCOPE_AGENT
#define LDS_WAIT() asm volatile("s_waitcnt lgkmcnt(0)" ::: "memory")
#define VM_WAIT() asm volatile("s_waitcnt vmcnt(0)" ::: "memory")
__device__ __forceinline__ unsigned long long rt() { return __builtin_amdgcn_s_memrealtime(); }
__device__ __forceinline__ unsigned f2bf(float f) { unsigned u = __builtin_bit_cast(unsigned, f); return (u + 0x7fffu + ((u >> 16) & 1u)) >> 16; }
__device__ __forceinline__ unsigned pk2(float lo, float hi) { return f2bf(lo) | (f2bf(hi) << 16); }

#define XB_TMO      128
#define XB_XCNT(j)  (256  + 64 * (j))
#define XB_XSUB(j)  (1280 + 64 * (j))
#define XB_XGEN(j)  (2304 + 64 * (j))
#define XB_TOP      3328
#define XB_TOPGEN   3392
#define XCD_BAR_WORDS 3456
#define XB_SPIN_CAP (1u << 18)

__device__ __forceinline__ unsigned xb_ld(unsigned* p)              { return __hip_atomic_load(p, __ATOMIC_RELAXED, __HIP_MEMORY_SCOPE_AGENT); }
__device__ __forceinline__ unsigned xb_add(unsigned* p, unsigned v) { return __hip_atomic_fetch_add(p, v, __ATOMIC_RELAXED, __HIP_MEMORY_SCOPE_AGENT); }
__device__ __forceinline__ unsigned xb_xcc_id() { return (unsigned)__builtin_amdgcn_s_getreg((3 << 11) | 20) & 0xFu; }
#define XB_SPIN(cond, bar) do { unsigned _sp = 0; while (cond) { __builtin_amdgcn_s_sleep(1); \
    if ((++_sp & 255u) == 0u) { if (xb_ld(&(bar)[XB_TMO])) break; if (_sp > XB_SPIN_CAP) { atomicAdd(&(bar)[XB_TMO], 1u); break; } } } } while (0)

struct XcdBarrier {
    unsigned* bar; unsigned x;
    volatile LAS unsigned* st;
};

__device__ __forceinline__ XcdBarrier xcd_barrier_post(unsigned* bar, volatile LAS unsigned* st) {
    XcdBarrier b; b.bar = bar; b.x = xb_xcc_id(); b.st = st;
    if (threadIdx.x == 0) (void)xb_add(&bar[XB_XCNT(b.x)], 1u);
    return b;
}
__device__ __forceinline__ void xcd_barrier_complete(unsigned* bar, unsigned x, unsigned& nloc, unsigned& nx) {
    const unsigned G = gridDim.x * gridDim.y * gridDim.z;
    unsigned sum, cnt, mine, sp = 0u;
    for (;;) {
        sum = 0u; cnt = 0u; mine = 0u;
#pragma unroll
        for (unsigned j = 0; j < 16; ++j) { const unsigned c = xb_ld(&bar[XB_XCNT(j)]); sum += c; cnt += (c > 0u) ? 1u : 0u; mine = (j == x) ? c : mine; }
        if (sum == G) break;
        __builtin_amdgcn_s_sleep(1);
        if ((++sp & 255u) == 0u) { if (xb_ld(&bar[XB_TMO])) break; if (sp > XB_SPIN_CAP) { atomicAdd(&bar[XB_TMO], 1u); break; } }
    }
    nloc = mine > 0u ? mine : 1u; nx = cnt > 0u ? cnt : 1u;
}

__device__ __forceinline__ void xcd_barrier(const XcdBarrier& b) {
    asm volatile("s_waitcnt vmcnt(0)" ::: "memory");
    __syncthreads();
    if (threadIdx.x == 0) {
        unsigned* bar = b.bar;
        __builtin_amdgcn_s_waitcnt(0);
        unsigned nloc = b.st[0], nx = b.st[1];
        if (nloc == 0u) { xcd_barrier_complete(bar, b.x, nloc, nx); b.st[0] = nloc; b.st[1] = nx; }
        const unsigned old = xb_add(&bar[XB_XSUB(b.x)], 1u);
        const unsigned gen = old / nloc;
        if (old + 1u == (gen + 1u) * nloc) {
            __builtin_amdgcn_fence(__ATOMIC_RELEASE, "agent");
            asm volatile("s_waitcnt vmcnt(0)" ::: "memory");
            const unsigned og = xb_add(&bar[XB_TOP], 1u);
            const unsigned tg = og / nx;
            if (og + 1u == (tg + 1u) * nx) xb_add(&bar[XB_TOPGEN], 1u);
            else XB_SPIN(xb_ld(&bar[XB_TOPGEN]) == tg, bar);
            __builtin_amdgcn_fence(__ATOMIC_ACQUIRE, "agent");
            xb_add(&bar[XB_XGEN(b.x)], 1u);
            asm volatile("s_waitcnt vmcnt(0)" ::: "memory");
        } else {
            XB_SPIN(xb_ld(&bar[XB_XGEN(b.x)]) == gen, bar);
            __builtin_amdgcn_fence(__ATOMIC_ACQUIRE, "agent");
            asm volatile("s_waitcnt vmcnt(0)" ::: "memory");
        }
    }
    __syncthreads();
}
__device__ __forceinline__ float wave_sum(float v) {
#pragma unroll
    for (int o = 1; o < 64; o <<= 1) v += __shfl_xor(v, o);
    return v;
}
__device__ __forceinline__ void p0_transpose_item(const float* W, int K, int N, bf16* WT, int row_off, LAS float* scr, int item, int lane) {
    const int nblk = N / 32, kb = item / nblk, nb = item % nblk, k0 = 64 * kb, n0 = 32 * nb;
#pragma unroll 8
    for (int i = 0; i < 32; ++i) { const int kk = 2 * i + (lane >> 5); scr[kk * 33 + (lane & 31)] = W[(size_t)(k0 + kk) * N + n0 + (lane & 31)]; }
    LDS_WAIT(); asm volatile("" ::: "memory");
    const int c = lane & 7;
#pragma unroll
    for (int j = 0; j < 4; ++j) { const int n = (lane >> 3) + 8 * j; const LAS float* s = scr + (8 * c) * 33 + n;
        v4u o; o.x = pk2(s[0 * 33], s[1 * 33]); o.y = pk2(s[2 * 33], s[3 * 33]); o.z = pk2(s[4 * 33], s[5 * 33]); o.w = pk2(s[6 * 33], s[7 * 33]);
        *(GAS v4u*)(WT + (size_t)(row_off + n0 + n) * K + k0 + 8 * c) = o; }
    LDS_WAIT(); asm volatile("" ::: "memory");
}

constexpr int NWAVES = 8;
constexpr int D = 2048, MP = 8192, MS = 256, MT = MP + MS, NMOD = 12288, NBM = 36;
constexpr int NQKVG = 12288, FF2 = 8192, DFF = 4096;
constexpr float EPS = 1e-6f;
constexpr size_t O_Y = 0, O_RETP = 17301504, O_RETS = 25690112, O_WKP = 92798976, O_WVP = 92930048, O_WKS = 93061120, O_WVS = 94109696, O_CONVP = 95158272, O_CONVS = 95420416, O_TOTAL = 97517568;
constexpr size_t MiB = 1u << 20;
constexpr size_t WS_CTL = 0, WS_MODS = 1 * MiB, WS_KVMODS = 8 * MiB, ZERO_BYTES = 9 * MiB;
constexpr size_t WS_RTR = 9 * MiB, WS_RTA = 12 * MiB;
constexpr size_t WS_X = 13 * MiB, WS_H = 79 * MiB, WS_HK = 112 * MiB, WS_QKVG = 145 * MiB, WS_U = 343 * MiB, WS_O = 475 * MiB, WS_A2 = 607 * MiB, WS_QA = 673 * MiB, WS_KV = 706 * MiB;
constexpr size_t WS_WIN = 715 * MiB, WS_WOUT = 811 * MiB, WS_WUP = 843 * MiB, WS_WDOWN = 971 * MiB, WS_WQ = 1035 * MiB, WS_WO = 1051 * MiB, WS_WKV = 1067 * MiB, WS_END = 1069 * MiB;
constexpr int CW_BAR = 4096;
constexpr int RING_BYTES = 131072, LDSCTL_OFF = RING_BYTES, MISC_OFF = LDSCTL_OFF + 320, LDS_BYTES = 147456;

struct Frame {
    LAS unsigned char* lds;
    volatile LAS unsigned* MISC;
    gu32* ctl;
    int tid, lane, wave, vcu, G;
    const float *x_prompt, *x_sample, *state_ret, *cache_k, *cache_v, *state_conv, *c_prompt, *c_sample, *w_ada, *b_ada, *norm_mix, *norm_ffn, *ret_w_in, *ret_gn, *ret_w_out,
                *kv_norm, *kv_w_ada, *kv_b_ada, *w_kv, *att_w_q, *att_sinks, *att_w_o, *ffn_w_up, *ffn_conv_w, *ffn_conv_b, *ffn_w_down, *norm_f;
    float* out;
    float *mods, *kvmods, *rtr, *rta, *X, *O;
    bf16 *H, *HK, *QKVG, *U, *A2, *QA, *KV, *WIN, *WOUT, *WUP, *WDOWN, *WQ, *WO, *WKV;
};
__device__ __forceinline__ unsigned cvtpk(float lo, float hi) { typedef float f32x2_t __attribute__((ext_vector_type(2))); typedef __bf16 bf16x2_t __attribute__((ext_vector_type(2)));
    f32x2_t v = {lo, hi}; bf16x2_t b = __builtin_convertvector(v, bf16x2_t); return __builtin_bit_cast(unsigned, b); }
__device__ __forceinline__ float bf2f(unsigned short h) { return __builtin_bit_cast(float, (unsigned)h << 16); }
__device__ __forceinline__ float bflo(unsigned w) { return __builtin_bit_cast(float, w << 16); }
__device__ __forceinline__ float bfhi(unsigned w) { return __builtin_bit_cast(float, w & 0xffff0000u); }
using pg8::bidx_of; using pg8::pidx_of;

__device__ __forceinline__ double exp_neg(double x) {
    const double n = __builtin_rint(x * 1.4426950408889634);
    double r = __builtin_fma(-n, 0.6931471805599453, x); r = __builtin_fma(-n, 2.3190468138462996e-17, r);
    double t = 1.0, s = 1.0;
#pragma unroll
    for (int k = 1; k <= 16; ++k) { t *= -r / (double)k; s += t; }
    return __builtin_ldexp(s, -(int)n);
}
__device__ __forceinline__ void sincos_f32ang(float ang, float& c, float& s) {
    const double a = (double)ang, n = __builtin_rint(a * 0.15915494309189535);
    double r = __builtin_fma(-n, 6.283185307179586, a); r = __builtin_fma(-n, 2.4492935982947064e-16, r);
    const double q = r * 0.25, q2 = q * q;
    double cs = 1.0, sn = 1.0, tc = 1.0, ts = 1.0;
#pragma unroll
    for (int k = 1; k <= 10; ++k) { tc *= -q2 / (double)((2 * k - 1) * (2 * k)); ts *= -q2 / (double)((2 * k) * (2 * k + 1)); cs += tc; sn += ts; }
    sn *= q;
#pragma unroll
    for (int k = 0; k < 2; ++k) { const double c2 = 2.0 * cs * cs - 1.0, s2 = 2.0 * sn * cs; cs = c2; sn = s2; }
    c = (float)cs; s = (float)sn;
}
__device__ __forceinline__ void p0_mods(Frame& F) {
    {
        LAS float* cs = (LAS float*)F.lds;
        for (int it = blockIdx.x; it < 416; it += F.G) {
            const int cb = it >> 3, kc = it & 7, k0 = kc * 256;
            const float* W; const float* bias; float* outp; int N, nb;
            if (cb < 48) { const int l = cb / 12; nb = cb % 12; W = F.w_ada + (size_t)l * D * NMOD; bias = F.b_ada + l * NMOD; outp = F.mods + (size_t)l * NBM * NMOD; N = NMOD; }
            else { nb = cb - 48; W = F.kv_w_ada; bias = F.kv_b_ada; outp = F.kvmods; N = 4096; }
            __syncthreads();
            for (int e = F.tid; e < NBM * 256; e += NWAVES * 64) { const int b = e >> 8, kk = e & 255;
                const float c = (b < 4) ? F.c_prompt[b * D + k0 + kk] : F.c_sample[(b - 4) * D + k0 + kk]; cs[e] = c / (1.0f + expf(-c)); }
            __syncthreads();
            const int col = nb * 1024 + F.wave * 128 + F.lane * 2;
            typedef float f32x2 __attribute__((ext_vector_type(2)));
            f32x2 acc[NBM];
#pragma unroll
            for (int b = 0; b < NBM; ++b) acc[b] = (f32x2){0.f, 0.f};
            const float* wp = W + (size_t)k0 * N + col;
            for (int kk = 0; kk < 256; kk += 4) {
                const f32x2 w0 = *(const f32x2*)(wp + (size_t)(kk + 0) * N), w1 = *(const f32x2*)(wp + (size_t)(kk + 1) * N), w2 = *(const f32x2*)(wp + (size_t)(kk + 2) * N), w3 = *(const f32x2*)(wp + (size_t)(kk + 3) * N);
#pragma unroll
                for (int b = 0; b < NBM; ++b) { const f32x4 c4 = *(const LAS f32x4*)(cs + b * 256 + kk); acc[b] += w0 * c4[0] + w1 * c4[1] + w2 * c4[2] + w3 * c4[3]; if ((b & 7) == 7) __builtin_amdgcn_sched_barrier(0); }
            }
            f32x2 bv = (f32x2){0.f, 0.f}; if (kc == 0) bv = *(const f32x2*)(bias + col);
#pragma unroll
            for (int b = 0; b < NBM; ++b) { float* o = outp + (size_t)b * N + col;
                __hip_atomic_fetch_add(o, acc[b][0] + bv[0], __ATOMIC_RELAXED, __HIP_MEMORY_SCOPE_AGENT); __hip_atomic_fetch_add(o + 1, acc[b][1] + bv[1], __ATOMIC_RELAXED, __HIP_MEMORY_SCOPE_AGENT); }
        }
        __syncthreads();
    }
}
__device__ __forceinline__ void p0_weights(Frame& F) {
    const int gw = F.vcu * NWAVES + F.wave, NGW = F.G * NWAVES;
    {
        LAS float* scr = (LAS float*)(F.lds + F.wave * 16384);
        constexpr int I_IN = 32 * 384, I_OUT = 64 * 64, I_KV = 32 * 16, I_Q = 32 * 64, I_UP = 32 * 256, I_DN = 64 * 64;
        constexpr int E0 = 2 * I_IN, E1 = E0 + 2 * I_OUT, E2 = E1 + I_KV, E3 = E2 + 2 * I_Q, E4 = E3 + 2 * I_Q, E5 = E4 + 4 * I_UP, E6 = E5 + 4 * I_DN;
        for (int it = gw; it < E6; it += NGW) {
            const float* W; bf16* WT; int K, N, r;
            if (it < E0)      { const int l = it / I_IN; r = it % I_IN; W = F.ret_w_in + (size_t)l * 2048 * 12288; WT = F.WIN + (size_t)l * 12288 * 2048; K = 2048; N = 12288; }
            else if (it < E1) { const int q = it - E0, l = q / I_OUT; r = q % I_OUT; W = F.ret_w_out + (size_t)l * 4096 * 2048; WT = F.WOUT + (size_t)l * 2048 * 4096; K = 4096; N = 2048; }
            else if (it < E2) { r = it - E1; W = F.w_kv; WT = F.WKV; K = 2048; N = 512; }
            else if (it < E3) { const int q = it - E2, l = q / I_Q; r = q % I_Q; W = F.att_w_q + (size_t)l * 2048 * 2048; WT = F.WQ + (size_t)l * 2048 * 2048; K = 2048; N = 2048; }
            else if (it < E4) { const int q = it - E3, l = q / I_Q; r = q % I_Q; W = F.att_w_o + (size_t)l * 2048 * 2048; WT = F.WO + (size_t)l * 2048 * 2048; K = 2048; N = 2048; }
            else if (it < E5) { const int q = it - E4, l = q / I_UP; r = q % I_UP; W = F.ffn_w_up + (size_t)l * 2048 * 8192; WT = F.WUP + (size_t)l * 8192 * 2048; K = 2048; N = 8192; }
            else              { const int q = it - E5, l = q / I_DN; r = q % I_DN; W = F.ffn_w_down + (size_t)l * 4096 * 2048; WT = F.WDOWN + (size_t)l * 2048 * 4096; K = 4096; N = 2048; }
            p0_transpose_item(W, K, N, WT, 0, scr, r, F.lane);
        }
    }
}
__device__ __forceinline__ void p0_tables(Frame& F) {
    const int gw = F.vcu * NWAVES + F.wave, NGW = F.G * NWAVES, gt = gw * 64 + F.lane, NGT = NGW * 64;
    for (int e = gt; e < 2056 * 136; e += NGT) {
        const int p = e / 136, i = e % 136; const float pos = (float)(p < 2048 ? p : 16384 + (p - 2048));
        float c, s;
        if (i < 128) { const float inv = (float)exp_neg((double)i * (9.210340371976184 / 128.0)); sincos_f32ang(pos * inv, c, s); F.rtr[((size_t)p * 128 + i) * 2] = c; F.rtr[((size_t)p * 128 + i) * 2 + 1] = s; }
        else { const int j = i - 128; const float inv = (float)exp_neg((double)j * (13.122363377404328 / 8.0)); sincos_f32ang(pos * inv, c, s); F.rta[((size_t)p * 8 + j) * 2] = c; F.rta[((size_t)p * 8 + j) * 2 + 1] = s; }
    }
}
__device__ __forceinline__ void p0_copies(Frame& F) {
    const int gw = F.vcu * NWAVES + F.wave, NGW = F.G * NWAVES, gt = gw * 64 + F.lane, NGT = NGW * 64;
    for (int e = gt; e < MT * D / 4; e += NGT) { const int pe = MP * D / 4;
        const f32x4 v = e < pe ? ((const f32x4*)F.x_prompt)[e] : ((const f32x4*)F.x_sample)[e - pe]; ((f32x4*)F.X)[e] = v; }
    for (int e = gt; e < 32 * 120 * 64; e += NGT) { const int sb = e / (120 * 64), r = e % (120 * 64);
        ((f32x4*)(F.out + O_WKS))[(size_t)sb * 128 * 64 + r] = ((const f32x4*)F.cache_k)[(size_t)sb * 128 * 64 + 8 * 64 + r];
        ((f32x4*)(F.out + O_WVS))[(size_t)sb * 128 * 64 + r] = ((const f32x4*)F.cache_v)[(size_t)sb * 128 * 64 + 8 * 64 + r]; }
}

__device__ __forceinline__ void t_norm_mod(Frame& F, const float* gv, const float* sh, const float* sc, int mstride, bf16* outp,
                                           const float* gv2, const float* sh2, const float* sc2, int mstride2, bf16* outp2) {
    const int gw = F.vcu * NWAVES + F.wave, NGW = F.G * NWAVES;
    for (int row = gw; row < MT; row += NGW) {
        const float* xr = F.X + (size_t)row * D + 4 * F.lane;
        f32x4 v[8]; float ss = 0.f;
#pragma unroll
        for (int j = 0; j < 8; ++j) { v[j] = *(const f32x4*)(xr + 256 * j); ss += (v[j][0] * v[j][0] + v[j][1] * v[j][1]) + (v[j][2] * v[j][2] + v[j][3] * v[j][3]); }
        const float rstd = 1.0f / sqrtf(wave_sum(ss) * (1.0f / D) + EPS);
        const int b = bidx_of(row);
#pragma unroll
        for (int j = 0; j < 8; ++j) { const int c = 4 * F.lane + 256 * j;
            const f32x4 g4 = *(const f32x4*)(gv + c), s4 = *(const f32x4*)(sc + (size_t)b * mstride + c), h4 = *(const f32x4*)(sh + (size_t)b * mstride + c);
            const f32x4 o = v[j] * rstd * g4 * (s4 + 1.0f) + h4;
            typedef unsigned u32x2 __attribute__((ext_vector_type(2)));
            u32x2 w; w.x = cvtpk(o[0], o[1]); w.y = cvtpk(o[2], o[3]); *(u32x2*)(outp + (size_t)row * D + c) = w; }
        if (gv2) {
#pragma unroll
            for (int j = 0; j < 8; ++j) { const int c = 4 * F.lane + 256 * j;
                const f32x4 g4 = *(const f32x4*)(gv2 + c), s4 = *(const f32x4*)(sc2 + (size_t)b * mstride2 + c), h4 = *(const f32x4*)(sh2 + (size_t)b * mstride2 + c);
                const f32x4 o = v[j] * rstd * g4 * (s4 + 1.0f) + h4;
                typedef unsigned u32x2 __attribute__((ext_vector_type(2)));
                u32x2 w; w.x = cvtpk(o[0], o[1]); w.y = cvtpk(o[2], o[3]); *(u32x2*)(outp2 + (size_t)row * D + c) = w; }
        }
    }
}
__device__ __forceinline__ void t_final_norm(Frame& F) {
    const int gw = F.vcu * NWAVES + F.wave, NGW = F.G * NWAVES;
    for (int row = gw; row < MT; row += NGW) {
        const float* xr = F.X + (size_t)row * D + 4 * F.lane;
        f32x4 v[8]; float ss = 0.f;
#pragma unroll
        for (int j = 0; j < 8; ++j) { v[j] = *(const f32x4*)(xr + 256 * j); ss += (v[j][0] * v[j][0] + v[j][1] * v[j][1]) + (v[j][2] * v[j][2] + v[j][3] * v[j][3]); }
        const float rstd = 1.0f / sqrtf(wave_sum(ss) * (1.0f / D) + EPS);
#pragma unroll
        for (int j = 0; j < 8; ++j) { const int c = 4 * F.lane + 256 * j; *(f32x4*)(F.out + O_Y + (size_t)row * D + c) = v[j] * rstd * *(const f32x4*)(F.norm_f + c); }
    }
}
__device__ __forceinline__ void t_gn_gate(Frame& F, int l) {
    const int gw = F.vcu * NWAVES + F.wave, NGW = F.G * NWAVES;
    const float* gn = F.ret_gn + (size_t)l * 4096;
    for (int it = gw; it < MT * 8; it += NGW) {
        const int row = it >> 3, h = it & 7, c = h * 512 + 8 * F.lane;
        const float* op = F.O + (size_t)row * 4096 + c;
        const f32x4 o0 = *(const f32x4*)(op), o1 = *(const f32x4*)(op + 4);
        const v4u gq = *(const v4u*)(F.QKVG + (size_t)row * NQKVG + 8192 + c);
        const f32x4 g0 = *(const f32x4*)(gn + c), g1 = *(const f32x4*)(gn + c + 4);
        const float mu = wave_sum((o0[0] + o0[1]) + (o0[2] + o0[3]) + (o1[0] + o1[1]) + (o1[2] + o1[3])) * (1.0f / 512.0f);
        const f32x4 d0 = o0 - mu, d1 = o1 - mu;
        const float var = wave_sum((d0[0] * d0[0] + d0[1] * d0[1]) + (d0[2] * d0[2] + d0[3] * d0[3]) + (d1[0] * d1[0] + d1[1] * d1[1]) + (d1[2] * d1[2] + d1[3] * d1[3])) * (1.0f / 512.0f);
        const float rstd = 1.0f / sqrtf(var + EPS);
        const f32x4 y0 = d0 * rstd * g0, y1 = d1 * rstd * g1;
        v4u w;
        w.x = cvtpk(bflo(gq.x) * y0[0], bfhi(gq.x) * y0[1]); w.y = cvtpk(bflo(gq.y) * y0[2], bfhi(gq.y) * y0[3]);
        w.z = cvtpk(bflo(gq.z) * y1[0], bfhi(gq.z) * y1[1]); w.w = cvtpk(bflo(gq.w) * y1[2], bfhi(gq.w) * y1[3]);
        *(v4u*)(F.A2 + (size_t)row * 4096 + c) = w;
    }
}
__device__ __forceinline__ void t_conv_gate(Frame& F, int l) {
    const int gw = F.vcu * NWAVES + F.wave, NGW = F.G * NWAVES;
    const float* cw = F.ffn_conv_w + (size_t)l * 3 * FF2; const float* cbv = F.ffn_conv_b + (size_t)l * FF2;
    for (int it = gw; it < (MT / 8) * 8; it += NGW) {
        const int run = it >> 3, cc = it & 7, r0 = run * 8, j0 = cc * 512 + 8 * F.lane;
        float pa2[8], pa1[8], pb2[8], pb1[8];
        const bool sample = r0 >= MP; const int t0 = sample ? 0 : (r0 & 2047);
        if (sample) {
            const float* sp = F.state_conv + ((size_t)(l * 32 + ((r0 - MP) >> 3)) * 2) * FF2;
#pragma unroll
            for (int e = 0; e < 8; ++e) { pa2[e] = sp[j0 + e]; pb2[e] = sp[4096 + j0 + e]; pa1[e] = sp[FF2 + j0 + e]; pb1[e] = sp[FF2 + 4096 + j0 + e]; }
        } else if (t0 == 0) {
#pragma unroll
            for (int e = 0; e < 8; ++e) { pa2[e] = 0.f; pb2[e] = 0.f; pa1[e] = 0.f; pb1[e] = 0.f; }
        } else {
            const v4u a2 = *(const v4u*)(F.U + (size_t)(r0 - 2) * FF2 + j0), b2 = *(const v4u*)(F.U + (size_t)(r0 - 2) * FF2 + 4096 + j0);
            const v4u a1 = *(const v4u*)(F.U + (size_t)(r0 - 1) * FF2 + j0), b1 = *(const v4u*)(F.U + (size_t)(r0 - 1) * FF2 + 4096 + j0);
#pragma unroll
            for (int q = 0; q < 4; ++q) { pa2[2 * q] = bflo(a2[q]); pa2[2 * q + 1] = bfhi(a2[q]); pb2[2 * q] = bflo(b2[q]); pb2[2 * q + 1] = bfhi(b2[q]);
                                          pa1[2 * q] = bflo(a1[q]); pa1[2 * q + 1] = bfhi(a1[q]); pb1[2 * q] = bflo(b1[q]); pb1[2 * q + 1] = bfhi(b1[q]); }
        }
        float wa[3][8], wb[3][8], ba[8], bb[8];
#pragma unroll
        for (int i = 0; i < 3; ++i) { const f32x4 x0 = *(const f32x4*)(cw + i * FF2 + j0), x1 = *(const f32x4*)(cw + i * FF2 + j0 + 4), y0 = *(const f32x4*)(cw + i * FF2 + 4096 + j0), y1 = *(const f32x4*)(cw + i * FF2 + 4096 + j0 + 4);
#pragma unroll
            for (int e = 0; e < 4; ++e) { wa[i][e] = x0[e]; wa[i][4 + e] = x1[e]; wb[i][e] = y0[e]; wb[i][4 + e] = y1[e]; } }
        { const f32x4 x0 = *(const f32x4*)(cbv + j0), x1 = *(const f32x4*)(cbv + j0 + 4), y0 = *(const f32x4*)(cbv + 4096 + j0), y1 = *(const f32x4*)(cbv + 4096 + j0 + 4);
#pragma unroll
            for (int e = 0; e < 4; ++e) { ba[e] = x0[e]; ba[4 + e] = x1[e]; bb[e] = y0[e]; bb[4 + e] = y1[e]; } }
        float* cst = nullptr;
        if (sample) cst = F.out + O_CONVS + ((size_t)(l * 32 + ((r0 - MP) >> 3)) * 2) * FF2;
        else if (t0 == 2040) cst = F.out + O_CONVP + ((size_t)(l * 4 + (r0 >> 11)) * 2) * FF2;
#pragma unroll
        for (int t = 0; t < 8; ++t) {
            const v4u ua = *(const v4u*)(F.U + (size_t)(r0 + t) * FF2 + j0), ub = *(const v4u*)(F.U + (size_t)(r0 + t) * FF2 + 4096 + j0);
            float ca[8], cb2[8], act[8];
#pragma unroll
            for (int q = 0; q < 4; ++q) { ca[2 * q] = bflo(ua[q]); ca[2 * q + 1] = bfhi(ua[q]); cb2[2 * q] = bflo(ub[q]); cb2[2 * q + 1] = bfhi(ub[q]); }
#pragma unroll
            for (int e = 0; e < 8; ++e) {
                const float za = ba[e] + wa[0][e] * pa2[e] + wa[1][e] * pa1[e] + wa[2][e] * ca[e];
                const float zb = bb[e] + wb[0][e] * pb2[e] + wb[1][e] * pb1[e] + wb[2][e] * cb2[e];
                act[e] = pg8::silu_f(za) * zb;
                pa2[e] = pa1[e]; pa1[e] = ca[e]; pb2[e] = pb1[e]; pb1[e] = cb2[e];
            }
            v4u w; w.x = cvtpk(act[0], act[1]); w.y = cvtpk(act[2], act[3]); w.z = cvtpk(act[4], act[5]); w.w = cvtpk(act[6], act[7]);
            *(v4u*)(F.A2 + (size_t)(r0 + t) * DFF + j0) = w;
            if (cst && t >= 6) { float* d = cst + (size_t)(t - 6) * FF2;
                *(f32x4*)(d + j0) = (f32x4){ca[0], ca[1], ca[2], ca[3]}; *(f32x4*)(d + j0 + 4) = (f32x4){ca[4], ca[5], ca[6], ca[7]};
                *(f32x4*)(d + 4096 + j0) = (f32x4){cb2[0], cb2[1], cb2[2], cb2[3]}; *(f32x4*)(d + 4096 + j0 + 4) = (f32x4){cb2[4], cb2[5], cb2[6], cb2[7]}; }
        }
    }
}

typedef unsigned u32x2_t __attribute__((ext_vector_type(2)));
__device__ __forceinline__ void ret_prompt_phase(Frame& F, int l) {
    LAS unsigned char* L = F.lds;
    constexpr int KS_STRIDE = 528, VT_STRIDE = 272, ST_STRIDE = 528, KS_OFF = 0, VT_OFF = 128 * KS_STRIDE, ST_OFF = VT_OFF + 64 * VT_STRIDE;
    static_assert(ST_OFF + 64 * ST_STRIDE <= RING_BYTES, "retention LDS");
    const int w = F.wave, lane = F.lane, fr = lane & 15, g = lane >> 4, tid = F.tid;
    const int rb = (w < 4) ? w : 11 - w;
    for (int unit = F.vcu; unit < 256; unit += F.G) {
        const int eb = unit & 7, h = (unit >> 3) & 7, b = unit >> 6;
        const float lg = log2f(1.0f - exp2f(-5.0f - (float)h));
        const float g128 = exp2f(128.0f * lg);
        f32x4 Sacc[2][4];
#pragma unroll
        for (int a = 0; a < 2; ++a)
#pragma unroll
            for (int e = 0; e < 4; ++e) Sacc[a][e] = (f32x4){0.f, 0.f, 0.f, 0.f};
        const bf16* Qh = F.QKVG + h * 256; const bf16* Kh = F.QKVG + 2048 + h * 256; const bf16* Vh = F.QKVG + 4096 + h * 512 + eb * 64;
        for (int c = 0; c < 16; ++c) {
            const size_t r0 = (size_t)b * 2048 + 128 * c;
            v4u kreg[8], vreg[2]; bf16x8 qf[8];
#pragma unroll
            for (int i = 0; i < 8; ++i) { const int p = tid + 512 * i; kreg[i] = *(const v4u*)(Kh + (r0 + (p >> 5)) * NQKVG + (p & 31) * 8); }
#pragma unroll
            for (int i = 0; i < 2; ++i) { const int p = tid + 512 * i; vreg[i] = *(const v4u*)(Vh + (r0 + (p & 127)) * NQKVG + (p >> 7) * 8); }
#pragma unroll
            for (int ks = 0; ks < 8; ++ks) qf[ks] = *(const bf16x8*)(Qh + (r0 + 16 * rb + fr) * NQKVG + 32 * ks + 8 * g);
            __syncthreads();
#pragma unroll
            for (int i = 0; i < 8; ++i) { const int p = tid + 512 * i; *(LAS v4u*)(L + KS_OFF + (p >> 5) * KS_STRIDE + (p & 31) * 16) = kreg[i]; }
#pragma unroll
            for (int i = 0; i < 2; ++i) { const int p = tid + 512 * i, m = p & 127, e8 = (p >> 7) * 8; const float kd = exp2f((float)(127 - m) * lg);
#pragma unroll
                for (int q = 0; q < 4; ++q) { const unsigned pk = cvtpk(bflo(vreg[i][q]) * kd, bfhi(vreg[i][q]) * kd);
                    *(LAS unsigned short*)(L + VT_OFF + (e8 + 2 * q) * VT_STRIDE + m * 2) = (unsigned short)(pk & 0xffffu);
                    *(LAS unsigned short*)(L + VT_OFF + (e8 + 2 * q + 1) * VT_STRIDE + m * 2) = (unsigned short)(pk >> 16); } }
#pragma unroll
            for (int dt = 0; dt < 2; ++dt)
#pragma unroll
                for (int et = 0; et < 4; ++et) { Sacc[dt][et] = Sacc[dt][et] * g128;
                    u32x2_t sw; sw.x = cvtpk(Sacc[dt][et][0], Sacc[dt][et][1]); sw.y = cvtpk(Sacc[dt][et][2], Sacc[dt][et][3]);
                    *(LAS u32x2_t*)(L + ST_OFF + (16 * et + fr) * ST_STRIDE + (32 * w + 16 * dt + 4 * g) * 2) = sw; }
            __syncthreads();
            f32x4 P[8];
#pragma unroll
            for (int t = 0; t < 8; ++t) {
                P[t] = (f32x4){0.f, 0.f, 0.f, 0.f};
                if (t <= rb) {
#pragma unroll
                    for (int ks = 0; ks < 8; ++ks) { const bf16x8 kf = *(const LAS bf16x8*)(L + KS_OFF + (16 * t + fr) * KS_STRIDE + (32 * ks + 8 * g) * 2);
                        P[t] = __builtin_amdgcn_mfma_f32_16x16x32_bf16(kf, qf[ks], P[t], 0, 0, 0); }
                    if (t == rb) {
#pragma unroll
                        for (int i = 0; i < 4; ++i) if (4 * g + i > fr) P[t][i] = 0.f;
                    }
                }
            }
            bf16x8 pa[4];
#pragma unroll
            for (int tp = 0; tp < 4; ++tp) { v4u pw; pw.x = cvtpk(P[2 * tp][0], P[2 * tp][1]); pw.y = cvtpk(P[2 * tp][2], P[2 * tp][3]); pw.z = cvtpk(P[2 * tp + 1][0], P[2 * tp + 1][1]); pw.w = cvtpk(P[2 * tp + 1][2], P[2 * tp + 1][3]);
                pa[tp] = __builtin_bit_cast(bf16x8, pw); }
            const float arow = exp2f((float)(16 * rb + fr - 127) * lg);
            float* orow = F.O + (r0 + 16 * rb + fr) * 4096 + h * 512 + eb * 64 + 4 * g;
#pragma unroll
            for (int et = 0; et < 4; ++et) {
                f32x4 oacc = (f32x4){0.f, 0.f, 0.f, 0.f};
#pragma unroll
                for (int tp = 0; tp < 4; ++tp) if (2 * tp <= rb) {
                    const LAS unsigned char* vp = L + VT_OFF + (16 * et + fr) * VT_STRIDE + (32 * tp + 4 * g) * 2;
                    const u32x2_t v0 = *(const LAS u32x2_t*)(vp), v1 = *(const LAS u32x2_t*)(vp + 32);
                    const v4u vv = (v4u){v0.x, v0.y, v1.x, v1.y};
                    oacc = __builtin_amdgcn_mfma_f32_16x16x32_bf16(__builtin_bit_cast(bf16x8, vv), pa[tp], oacc, 0, 0, 0); }
#pragma unroll
                for (int ks = 0; ks < 8; ++ks) { const bf16x8 sf = *(const LAS bf16x8*)(L + ST_OFF + (16 * et + fr) * ST_STRIDE + (32 * ks + 8 * g) * 2);
                    oacc = __builtin_amdgcn_mfma_f32_16x16x32_bf16(sf, qf[ks], oacc, 0, 0, 0); }
                *(f32x4*)(orow + 16 * et) = oacc * arow;
            }
#pragma unroll
            for (int tp = 0; tp < 4; ++tp) {
                bf16x8 vf[4];
#pragma unroll
                for (int et = 0; et < 4; ++et) { const LAS unsigned char* vp = L + VT_OFF + (16 * et + fr) * VT_STRIDE + (32 * tp + 4 * g) * 2;
                    const u32x2_t v0 = *(const LAS u32x2_t*)(vp), v1 = *(const LAS u32x2_t*)(vp + 32); const v4u vv = (v4u){v0.x, v0.y, v1.x, v1.y}; vf[et] = __builtin_bit_cast(bf16x8, vv); }
#pragma unroll
                for (int dt = 0; dt < 2; ++dt) {
                    const LAS unsigned char* kp = L + KS_OFF + (32 * tp + 4 * g) * KS_STRIDE + (32 * w + 16 * dt + fr) * 2;
                    unsigned short kk[8];
#pragma unroll
                    for (int j = 0; j < 4; ++j) { kk[j] = *(const LAS unsigned short*)(kp + j * KS_STRIDE); kk[4 + j] = *(const LAS unsigned short*)(kp + (16 + j) * KS_STRIDE); }
                    v4u kw; kw.x = (unsigned)kk[0] | ((unsigned)kk[1] << 16); kw.y = (unsigned)kk[2] | ((unsigned)kk[3] << 16); kw.z = (unsigned)kk[4] | ((unsigned)kk[5] << 16); kw.w = (unsigned)kk[6] | ((unsigned)kk[7] << 16);
                    const bf16x8 ktf = __builtin_bit_cast(bf16x8, kw);
#pragma unroll
                    for (int et = 0; et < 4; ++et) Sacc[dt][et] = __builtin_amdgcn_mfma_f32_16x16x32_bf16(ktf, vf[et], Sacc[dt][et], 0, 0, 0);
                }
            }
        }
        float* sp = F.out + O_RETP + ((size_t)((l * 4 + b) * 8 + h) * 256) * 512 + eb * 64;
#pragma unroll
        for (int dt = 0; dt < 2; ++dt)
#pragma unroll
            for (int et = 0; et < 4; ++et)
#pragma unroll
                for (int i = 0; i < 4; ++i) sp[(size_t)(32 * w + 16 * dt + 4 * g + i) * 512 + 16 * et + fr] = Sacc[dt][et][i];
    }
}

__device__ __forceinline__ void ret_sample_phase(Frame& F, int l) {
    LAS float* Lq = (LAS float*)F.lds;
    LAS float* Lk = Lq + 2048;
    LAS float* Lt = Lk + 2048;
    LAS float* La = Lt + 4096;
    LAS float* Lr = La + 64;
    const int tid = F.tid, e4 = tid & 127, dq = tid >> 7, e = 4 * e4;
    for (int unit = F.vcu; unit < 256; unit += F.G) {
        const int sb = unit >> 3, h = unit & 7;
        const float lg = log2f(1.0f - exp2f(-5.0f - (float)h));
        const size_t r0 = (size_t)MP + 8 * sb;
        __syncthreads();
        for (int i = tid; i < 4096; i += 512) { const int which = i >> 11, t = (i >> 8) & 7, d = i & 255;
            const float v = bf2f(F.QKVG[(r0 + t) * NQKVG + which * 2048 + h * 256 + d]); (which ? Lk : Lq)[t * 256 + d] = v; }
        __syncthreads();
        if (tid < 64) { const int t = tid >> 3, m = tid & 7; float s = 0.f;
            for (int d = 0; d < 256; ++d) s += Lq[t * 256 + d] * Lk[m * 256 + d];
            La[tid] = (m <= t) ? s * exp2f((float)(t - m) * lg) : 0.f; }
        for (int i = tid; i < 4096; i += 512) { const int d = i >> 4, j = i & 15;
            Lt[i] = (j < 8) ? Lq[j * 256 + d] * exp2f((float)(j + 1) * lg) : Lk[(j - 8) * 256 + d] * exp2f((float)(15 - j) * lg); }
        f32x4 vv[8];
#pragma unroll
        for (int m = 0; m < 8; ++m) { typedef unsigned u32x2 __attribute__((ext_vector_type(2)));
            const u32x2 q = *(const u32x2*)(F.QKVG + (r0 + m) * NQKVG + 4096 + h * 512 + e); vv[m] = (f32x4){bflo(q.x), bfhi(q.x), bflo(q.y), bfhi(q.y)}; }
        __syncthreads();
        const float g8 = exp2f(8.0f * lg);
        const float* Sin = F.state_ret + ((size_t)((l * 32 + sb) * 8 + h) * 256) * 512 + e;
        float* Sout = F.out + O_RETS + ((size_t)((l * 32 + sb) * 8 + h) * 256) * 512 + e;
        f32x4 oacc[8];
#pragma unroll
        for (int t = 0; t < 8; ++t) oacc[t] = (f32x4){0.f, 0.f, 0.f, 0.f};
        for (int i0 = 0; i0 < 64; i0 += 4) {
            f32x4 s[4];
#pragma unroll
            for (int u = 0; u < 4; ++u) s[u] = *(const f32x4*)(Sin + (size_t)(4 * (i0 + u) + dq) * 512);
#pragma unroll
            for (int u = 0; u < 4; ++u) { const int d = 4 * (i0 + u) + dq;
                const f32x4 q0 = *(const LAS f32x4*)(Lt + d * 16), q1 = *(const LAS f32x4*)(Lt + d * 16 + 4), k0 = *(const LAS f32x4*)(Lt + d * 16 + 8), k1 = *(const LAS f32x4*)(Lt + d * 16 + 12);
#pragma unroll
                for (int t = 0; t < 4; ++t) { oacc[t] += s[u] * q0[t]; oacc[4 + t] += s[u] * q1[t]; }
                f32x4 sn = s[u] * g8;
#pragma unroll
                for (int m = 0; m < 4; ++m) { sn += vv[m] * k0[m]; sn += vv[4 + m] * k1[m]; }
                *(f32x4*)(Sout + (size_t)d * 512) = sn; }
        }
#pragma unroll
        for (int t = 0; t < 8; ++t) *(LAS f32x4*)(Lr + (dq * 8 + t) * 512 + e) = oacc[t];
        __syncthreads();
#pragma unroll
        for (int tt = 0; tt < 2; ++tt) { const int t = 2 * dq + tt;
            f32x4 o = *(const LAS f32x4*)(Lr + (0 * 8 + t) * 512 + e) + *(const LAS f32x4*)(Lr + (1 * 8 + t) * 512 + e) + *(const LAS f32x4*)(Lr + (2 * 8 + t) * 512 + e) + *(const LAS f32x4*)(Lr + (3 * 8 + t) * 512 + e);
#pragma unroll
            for (int m = 0; m < 8; ++m) o += vv[m] * La[t * 8 + m];
            *(f32x4*)(F.O + (r0 + t) * 4096 + h * 512 + e) = o; }
    }
}

__device__ __forceinline__ void attn_prompt_phase(Frame& F, int j) {
    LAS unsigned char* L = F.lds;
    constexpr int KB_STRIDE = 144, VT_STRIDE = 528, KB_OFF = 0, VT_OFF = 256 * KB_STRIDE;
    static_assert(VT_OFF + 64 * VT_STRIDE <= RING_BYTES, "attention LDS");
    const int w = F.wave, lane = F.lane, fr = lane & 15, g = lane >> 4, tid = F.tid;
    for (int unit = F.vcu; unit < 256; unit += F.G) {
        const int qblk = unit & 15, kvh = (unit >> 4) & 3, b = unit >> 6, hq = kvh * 8 + w;
        const float sink = F.att_sinks[j * 32 + hq];
        const size_t rowb = (size_t)b * 2048; const int q0 = qblk * 128;
        __syncthreads();
#pragma unroll
        for (int i = 0; i < 4; ++i) { const int p = tid + 512 * i, kk = p >> 3, c8 = (p & 7) * 8, pos = q0 - 128 + kk;
            v4u kv = (v4u){0u, 0u, 0u, 0u}; if (pos >= 0) kv = *(const v4u*)(F.KV + (rowb + pos) * 512 + kvh * 64 + c8);
            *(LAS v4u*)(L + KB_OFF + kk * KB_STRIDE + c8 * 2) = kv; }
#pragma unroll
        for (int i = 0; i < 4; ++i) { const int p = tid + 512 * i, kk = p & 255, c8 = (p >> 8) * 8, pos = q0 - 128 + kk;
            v4u vv = (v4u){0u, 0u, 0u, 0u}; if (pos >= 0) vv = *(const v4u*)(F.KV + (rowb + pos) * 512 + 256 + kvh * 64 + c8);
#pragma unroll
            for (int q = 0; q < 4; ++q) { *(LAS unsigned short*)(L + VT_OFF + (c8 + 2 * q) * VT_STRIDE + kk * 2) = (unsigned short)(vv[q] & 0xffffu);
                                          *(LAS unsigned short*)(L + VT_OFF + (c8 + 2 * q + 1) * VT_STRIDE + kk * 2) = (unsigned short)(vv[q] >> 16); } }
        __syncthreads();
        for (int rbk = 0; rbk < 8; ++rbk) {
            const size_t qrow = rowb + q0 + 16 * rbk + fr;
            bf16x8 qf[2];
#pragma unroll
            for (int ks = 0; ks < 2; ++ks) qf[ks] = *(const bf16x8*)(F.QA + qrow * 2048 + hq * 64 + 32 * ks + 8 * g);
            f32x4 S[10]; float mx = sink;
#pragma unroll
            for (int tl = 0; tl < 9; ++tl) {
                f32x4 s = (f32x4){0.f, 0.f, 0.f, 0.f};
#pragma unroll
                for (int ks = 0; ks < 2; ++ks) { const bf16x8 kf = *(const LAS bf16x8*)(L + KB_OFF + (16 * (rbk + tl) + fr) * KB_STRIDE + (32 * ks + 8 * g) * 2);
                    s = __builtin_amdgcn_mfma_f32_16x16x32_bf16(kf, qf[ks], s, 0, 0, 0); }
#pragma unroll
                for (int i = 0; i < 4; ++i) { const int rel = 128 - 16 * tl + fr - (4 * g + i); const int kpos = q0 - 128 + 16 * (rbk + tl) + 4 * g + i;
                    const bool ok = (rel >= 0) && (rel <= 128) && (kpos >= 0);
                    s[i] = ok ? s[i] * 0.125f : -1e30f; mx = fmaxf(mx, s[i]); }
                S[tl] = s;
            }
            mx = fmaxf(mx, __shfl_xor(mx, 16)); mx = fmaxf(mx, __shfl_xor(mx, 32));
            float den = 0.f;
#pragma unroll
            for (int tl = 0; tl < 9; ++tl)
#pragma unroll
                for (int i = 0; i < 4; ++i) { const float p = __expf(S[tl][i] - mx); S[tl][i] = p; den += p; }
            S[9] = (f32x4){0.f, 0.f, 0.f, 0.f};
            den += __shfl_xor(den, 16); den += __shfl_xor(den, 32);
            den += __expf(sink - mx);
            const float rden = 1.0f / den;
            bf16* orow = F.A2 + qrow * 2048 + hq * 64 + 4 * g;
#pragma unroll
            for (int dt = 0; dt < 4; ++dt) {
                f32x4 oacc = (f32x4){0.f, 0.f, 0.f, 0.f};
#pragma unroll
                for (int tp = 0; tp < 5; ++tp) {
                    v4u pw; pw.x = cvtpk(S[2 * tp][0], S[2 * tp][1]); pw.y = cvtpk(S[2 * tp][2], S[2 * tp][3]); pw.z = cvtpk(S[2 * tp + 1][0], S[2 * tp + 1][1]); pw.w = cvtpk(S[2 * tp + 1][2], S[2 * tp + 1][3]);
                    const int k0 = 16 * (rbk + 2 * tp) + 4 * g; int k1 = k0 + 16; if (k1 > 252) k1 = 252;
                    const u32x2_t v0 = *(const LAS u32x2_t*)(L + VT_OFF + (16 * dt + fr) * VT_STRIDE + k0 * 2), v1 = *(const LAS u32x2_t*)(L + VT_OFF + (16 * dt + fr) * VT_STRIDE + k1 * 2);
                    const v4u vv = (v4u){v0.x, v0.y, v1.x, v1.y};
                    oacc = __builtin_amdgcn_mfma_f32_16x16x32_bf16(__builtin_bit_cast(bf16x8, vv), __builtin_bit_cast(bf16x8, pw), oacc, 0, 0, 0);
                }
                u32x2_t ow; ow.x = cvtpk(oacc[0] * rden, oacc[1] * rden); ow.y = cvtpk(oacc[2] * rden, oacc[3] * rden);
                *(u32x2_t*)(orow + 16 * dt) = ow;
            }
        }
    }
}

__device__ __forceinline__ void attn_sample_phase(Frame& F, int j) {
    LAS float* Kc = (LAS float*)F.lds;
    LAS float* Vc = Kc + 136 * 65;
    LAS float* Pw = Vc + 136 * 65 + F.wave * 192;
    const int w = F.wave, lane = F.lane, tid = F.tid;
    for (int unit = F.vcu; unit < 128; unit += F.G) {
        const int sb = unit >> 2, kvh = unit & 3, hq = kvh * 8 + w;
        const float sink = F.att_sinks[j * 32 + hq];
        const size_t r0 = (size_t)MP + 8 * sb;
        __syncthreads();
        for (int i = tid; i < 136 * 64; i += 512) { const int kk = i >> 6, d = i & 63; float kv, vv;
            if (kk < 128) { kv = F.cache_k[((size_t)(sb * 128 + kk) * 4 + kvh) * 64 + d]; vv = F.cache_v[((size_t)(sb * 128 + kk) * 4 + kvh) * 64 + d]; }
            else { kv = bf2f(F.KV[(r0 + kk - 128) * 512 + kvh * 64 + d]); vv = bf2f(F.KV[(r0 + kk - 128) * 512 + 256 + kvh * 64 + d]); }
            Kc[kk * 65 + d] = kv; Vc[kk * 65 + d] = vv; }
        __syncthreads();
        for (int t = 0; t < 8; ++t) {
            const float qv = bf2f(F.QA[(r0 + t) * 2048 + hq * 64 + lane]);
            float s0 = 0.f, s1 = 0.f, s2 = 0.f; const int k2 = (lane < 8) ? 128 + lane : 135;
            for (int d = 0; d < 64; ++d) { const float qd = __shfl(qv, d); s0 += qd * Kc[lane * 65 + d]; s1 += qd * Kc[(64 + lane) * 65 + d]; s2 += qd * Kc[k2 * 65 + d]; }
            const bool ok0 = lane >= t, ok1 = true, ok2 = (lane < 8) && (lane <= t);
            s0 = ok0 ? s0 * 0.125f : -1e30f; s1 = ok1 ? s1 * 0.125f : -1e30f; s2 = ok2 ? s2 * 0.125f : -1e30f;
            float mx = fmaxf(fmaxf(s0, s1), fmaxf(s2, sink));
#pragma unroll
            for (int o = 1; o < 64; o <<= 1) mx = fmaxf(mx, __shfl_xor(mx, o));
            const float p0 = __expf(s0 - mx), p1 = __expf(s1 - mx), p2 = (lane < 8) ? __expf(s2 - mx) : 0.f;
            const float den = wave_sum(p0 + p1 + p2) + __expf(sink - mx);
            Pw[lane] = p0; Pw[64 + lane] = p1; if (lane < 8) Pw[128 + lane] = p2;
            LDS_WAIT(); asm volatile("" ::: "memory");
            float o = 0.f;
            for (int kk = 0; kk < 136; ++kk) o += Pw[kk] * Vc[kk * 65 + lane];
            F.A2[(r0 + t) * 2048 + hq * 64 + lane] = (bf16)(cvtpk(o / den, 0.f) & 0xffffu);
            LDS_WAIT(); asm volatile("" ::: "memory");
        }
    }
}

#ifndef MK_MULTI
#define MK_MULTI 0
#endif
constexpr int N_PHASES = 36;

__device__ __forceinline__ void frame_refresh(Frame& F) {
    extern __shared__ __attribute__((aligned(16))) unsigned char lds[];
    int t_ = threadIdx.x; asm volatile("" : "+v"(t_));
    F.tid = t_; F.lane = t_ & 63; F.wave = __builtin_amdgcn_readfirstlane(t_ >> 6);
    F.lds = (LAS unsigned char*)lds;
    F.MISC = (volatile LAS unsigned*)(F.lds + MISC_OFF);
    const __attribute__((address_space(4))) unsigned char* ka = (const __attribute__((address_space(4))) unsigned char*)__builtin_amdgcn_kernarg_segment_ptr();
    asm volatile("" : "+s"(ka));
#define KIN(k) (*(const float* const __attribute__((address_space(4)))*)(ka + 8 * (k)))
    F.x_prompt = KIN(0); F.x_sample = KIN(1); F.state_ret = KIN(2); F.cache_k = KIN(3); F.cache_v = KIN(4); F.state_conv = KIN(5); F.c_prompt = KIN(6); F.c_sample = KIN(7);
    F.w_ada = KIN(8); F.b_ada = KIN(9); F.norm_mix = KIN(10); F.norm_ffn = KIN(11); F.ret_w_in = KIN(12); F.ret_gn = KIN(13); F.ret_w_out = KIN(14);
    F.kv_norm = KIN(15); F.kv_w_ada = KIN(16); F.kv_b_ada = KIN(17); F.w_kv = KIN(18); F.att_w_q = KIN(19); F.att_sinks = KIN(20); F.att_w_o = KIN(21);
    F.ffn_w_up = KIN(22); F.ffn_conv_w = KIN(23); F.ffn_conv_b = KIN(24); F.ffn_w_down = KIN(25); F.norm_f = KIN(26);
    F.out = (float*)KIN(27);
    unsigned char* ws = (unsigned char*)KIN(28);
#undef KIN
    F.ctl = (gu32*)(ws + WS_CTL);
    F.mods = (float*)(ws + WS_MODS); F.kvmods = (float*)(ws + WS_KVMODS); F.rtr = (float*)(ws + WS_RTR); F.rta = (float*)(ws + WS_RTA); F.X = (float*)(ws + WS_X); F.O = (float*)(ws + WS_O);
    F.H = (bf16*)(ws + WS_H); F.HK = (bf16*)(ws + WS_HK); F.QKVG = (bf16*)(ws + WS_QKVG); F.U = (bf16*)(ws + WS_U); F.A2 = (bf16*)(ws + WS_A2); F.QA = (bf16*)(ws + WS_QA); F.KV = (bf16*)(ws + WS_KV);
    F.WIN = (bf16*)(ws + WS_WIN); F.WOUT = (bf16*)(ws + WS_WOUT); F.WUP = (bf16*)(ws + WS_WUP); F.WDOWN = (bf16*)(ws + WS_WDOWN); F.WQ = (bf16*)(ws + WS_WQ); F.WO = (bf16*)(ws + WS_WO); F.WKV = (bf16*)(ws + WS_WKV);
}
struct Args { const float* in[27]; float* out; unsigned char* ws; int ph_lo, ph_hi, use_bar, pad; };
__global__ void __launch_bounds__(NWAVES * 64, 2) yoco_fwd(Args args) {
    extern __shared__ __attribute__((aligned(16))) unsigned char lds[];
    Frame F;
    F.G = gridDim.x; { const int bx = blockIdx.x; F.vcu = (F.G % 8 == 0) ? (bx % 8) * (F.G / 8) + bx / 8 : bx; }
    frame_refresh(F);
    for (int u = F.tid; u < (LDS_BYTES - LDSCTL_OFF) / 4; u += NWAVES * 64) ((LAS unsigned*)(F.lds + LDSCTL_OFF))[u] = 0u;
    __syncthreads();
    XcdBarrier bar; bar.bar = (unsigned*)(args.ws + WS_CTL) + CW_BAR; bar.x = 0; bar.st = (volatile LAS unsigned*)(F.lds + MISC_OFF) + 8;
    if (args.use_bar) bar = xcd_barrier_post(bar.bar, bar.st);
    const int lo = args.ph_lo, hi = args.ph_hi;
    int ph = 0;
#ifndef EN_MASK
#define EN_MASK 0xffffffffu
#endif
#define EN(k) ((EN_MASK >> (k)) & 1u)
#define PH_ON ((ph >= lo && ph < hi) && (frame_refresh(F), true))
#define PH_END do { if (ph >= lo && ph + 1 < hi) xcd_barrier(bar); ++ph; } while (0)

    if (PH_ON && EN(0)) { p0_mods(F); frame_refresh(F); p0_weights(F); frame_refresh(F); p0_tables(F); frame_refresh(F); p0_copies(F); }
    PH_END;

    for (int l = 0; l < 4; ++l) {
        #define md (F.mods + (size_t)l * NBM * NMOD)
        if (PH_ON && EN(1)) {
            if (l == 2) t_norm_mod(F, F.norm_mix + l * D, md, md + D, NMOD, F.H, F.kv_norm, F.kvmods, F.kvmods + D, 4096, F.HK);
            else        t_norm_mod(F, F.norm_mix + l * D, md, md + D, NMOD, F.H, nullptr, nullptr, nullptr, 0, nullptr);
        }
        PH_END;
        if (l < 2) {
            if (PH_ON && EN(2)) { pg8::Gemm g{F.H, F.WIN + (size_t)l * NQKVG * D, MT, NQKVG, D}; pg8::StaticOrder S; S.init(MT, NQKVG, F.G, (int)blockIdx.x);
                pg8::EpiRetIn E{F.QKVG, F.rtr};
                pg8::gemm_phase<pg8::EpiRetIn, pg8::StaticOrder, true, true>(F.lds, g, S, E); }
            PH_END;
            if (PH_ON) { if (EN(3)) ret_prompt_phase(F, l); if (EN(4)) ret_sample_phase(F, l); }
            PH_END;
            if (PH_ON && EN(5)) t_gn_gate(F, l);
            PH_END;
        } else {
            const int j = l - 2;
            if (PH_ON && EN(6)) {
                { pg8::Gemm g{F.H, F.WQ + (size_t)j * D * D, MT, D, D}; pg8::StaticOrder S; S.init(MT, D, F.G, (int)blockIdx.x);
                  pg8::EpiHead E{F.QA, D, F.rta, 8, nullptr, nullptr, nullptr, nullptr};
                  pg8::gemm_phase<pg8::EpiHead, pg8::StaticOrder, true, true>(F.lds, g, S, E); }
                if (l == 2) { pg8::Gemm g{F.HK, F.WKV, MT, 512, D}; pg8::StaticOrder S; S.init(MT, 512, F.G, (int)blockIdx.x);
                  pg8::EpiHead E{F.KV, 512, F.rta, 1, F.out + O_WKP, F.out + O_WVP, F.out + O_WKS, F.out + O_WVS};
                  pg8::gemm_phase<pg8::EpiHead, pg8::StaticOrder, true, true>(F.lds, g, S, E); }
            }
            PH_END;
            if (PH_ON) { if (EN(7)) attn_prompt_phase(F, j); if (EN(8)) attn_sample_phase(F, j); }
            PH_END;
        }
        if (PH_ON && EN(9)) {
            const bf16* Bt = (l < 2) ? F.WOUT + (size_t)l * D * 4096 : F.WO + (size_t)(l - 2) * D * D; const int K = (l < 2) ? 4096 : D;
            pg8::Gemm g{F.A2, Bt, MT, D, K}; pg8::StaticOrder S; S.init(MT, D, F.G, (int)blockIdx.x);
            pg8::EpiResid E{F.X, md + 2 * D};
            pg8::gemm_phase<pg8::EpiResid, pg8::StaticOrder, true, true>(F.lds, g, S, E);
        }
        PH_END;
        if (PH_ON && EN(10)) t_norm_mod(F, F.norm_ffn + l * D, md + 3 * D, md + 4 * D, NMOD, F.H, nullptr, nullptr, nullptr, 0, nullptr);
        PH_END;
        if (PH_ON && EN(11)) { pg8::Gemm g{F.H, F.WUP + (size_t)l * FF2 * D, MT, FF2, D}; pg8::StaticOrder S; S.init(MT, FF2, F.G, (int)blockIdx.x);
            pg8::EpiPlain E{F.U, FF2};
            pg8::gemm_phase<pg8::EpiPlain, pg8::StaticOrder, true, true>(F.lds, g, S, E); }
        PH_END;
        if (PH_ON && EN(12)) t_conv_gate(F, l);
        PH_END;
        if (PH_ON && EN(13)) { pg8::Gemm g{F.A2, F.WDOWN + (size_t)l * D * DFF, MT, D, DFF}; pg8::StaticOrder S; S.init(MT, D, F.G, (int)blockIdx.x);
            pg8::EpiResid E{F.X, md + 5 * D};
            pg8::gemm_phase<pg8::EpiResid, pg8::StaticOrder, true, true>(F.lds, g, S, E); }
        PH_END;
    }
    if (PH_ON && EN(14)) t_final_norm(F);
#undef md
#undef PH_ON
#undef PH_END
}

extern "C" void kernel_launch(void* const* d_in, const int* in_sizes, int n_in, void* d_out, int out_size, void* d_ws, size_t ws_size, hipStream_t stream) {
    static int grid = 0;
    if (grid == 0) {
        if (n_in != 27 || (size_t)out_size != O_TOTAL || ws_size < WS_END) { fprintf(stderr, "kernel_launch: unexpected problem: n_in %d out %d ws %zu (need 27, %zu, >= %zu); nothing launched\n", n_in, out_size, ws_size, (size_t)O_TOTAL, (size_t)WS_END); grid = -1; return; }
        int dev = 0, cus = 0, per_cu = 0;
        if (hipGetDevice(&dev) != hipSuccess || hipDeviceGetAttribute(&cus, hipDeviceAttributeMultiprocessorCount, dev) != hipSuccess) { fprintf(stderr, "kernel_launch: device query failed\n"); grid = -1; return; }
        if (hipFuncSetAttribute((const void*)yoco_fwd, hipFuncAttributeMaxDynamicSharedMemorySize, LDS_BYTES) != hipSuccess) { fprintf(stderr, "kernel_launch: hipFuncSetAttribute failed\n"); grid = -1; return; }
        if (hipOccupancyMaxActiveBlocksPerMultiprocessor(&per_cu, (const void*)yoco_fwd, NWAVES * 64, LDS_BYTES) != hipSuccess || per_cu < 1)
            fprintf(stderr, "kernel_launch: note: occupancy query reports %d workgroups per CU\n", per_cu);
        (void)hipGetLastError();
        grid = cus;
    }
    if (grid < 0) return;
    if (hipMemsetAsync((char*)d_ws + WS_CTL, 0, ZERO_BYTES, stream) != hipSuccess) { fprintf(stderr, "kernel_launch: hipMemsetAsync failed\n"); return; }
    Args a{};
    for (int i = 0; i < 27; ++i) a.in[i] = (const float*)d_in[i];
    a.out = (float*)d_out; a.ws = (unsigned char*)d_ws; a.pad = 0;
#if MK_MULTI
    for (int p = 0; p < N_PHASES; ++p) { a.ph_lo = p; a.ph_hi = p + 1; a.use_bar = 0;
        hipLaunchKernelGGL(yoco_fwd, dim3(grid), dim3(NWAVES * 64), LDS_BYTES, stream, a); }
#else
    a.ph_lo = 0; a.ph_hi = N_PHASES; a.use_bar = 1;
    hipLaunchKernelGGL(yoco_fwd, dim3(grid), dim3(NWAVES * 64), LDS_BYTES, stream, a);
#endif
    const hipError_t le = hipPeekAtLastError();
    if (le != hipSuccess) fprintf(stderr, "kernel_launch: launch failed: %s\n", hipGetErrorName(le));
}
```

```cpp
#include <hip/hip_runtime.h>
#include <cstdio>
#include <cstdint>
namespace pg8 {
#define PG8_LAS __attribute__((address_space(3)))
typedef unsigned short bf16_t;
typedef short bf16x8 __attribute__((ext_vector_type(8)));
typedef float f32x4 __attribute__((ext_vector_type(4)));
typedef unsigned u32x4 __attribute__((ext_vector_type(4)));
constexpr int BM = 256, BK = 64, HALF = 128, HTB = HALF * BK * 2  , STAGE_BYTES = 8 * HTB, NXCD = 8, WGM = 8;

__host__ __device__ __forceinline__ int lds_byte(int r, int c) { const int st = (r >> 4) * 2 + (c >> 5), rr = r & 15, cc = c & 31, ob = rr * 64 + cc * 2; return st * 1024 + (ob ^ (((ob >> 9) & 1) << 5)); }
__host__ __device__ __forceinline__ void stage_rc(int b, int& R, int& C) { const int st = b / 1024, sb = b % 1024, swz = sb ^ (((sb >> 9) & 1) << 5); R = (st >> 1) * 16 + swz / 64; C = (st & 1) * 32 + (swz % 64) / 2; }
__host__ __device__ __forceinline__ int perm32(int rho) { const int n = rho >> 4, i = rho & 15; return 8 * (i >> 2) + 4 * n + (i & 3); }

struct Unit { int pm, pn; };
struct Gemm { const bf16_t* A; const bf16_t* Bt; int M, N, K; };

struct StaticOrder {
    int nM, nN, nwg, G, c;
    __host__ __device__ void init(int M, int N, int G_, int c_) { nM = M / BM; nN = N / BM; nwg = nM * nN; G = G_; c = c_; }
    __host__ __device__ bool next(int i, Unit& u) const {
        const long L = (long)i * G + c; if (L >= nwg) return false;
        int wgid = (int)L; { const int q = nwg / NXCD, r = nwg % NXCD, xcd = wgid % NXCD, off = wgid / NXCD; wgid = (xcd < r ? xcd * (q + 1) : r * (q + 1) + (xcd - r) * q) + off; }
        const int nig = WGM * nN, gid = wgid / nig, fm = gid * WGM, gsz = (nM - fm) < WGM ? (nM - fm) : WGM;
        u.pm = fm + ((wgid % nig) % gsz); u.pn = (wgid % nig) / gsz; return true;
    }
    __device__ __forceinline__ void a_ready(const Unit&) const {}
    __device__ __forceinline__ void done(const Unit&) const {}
};

__device__ __forceinline__ unsigned cvt_pk_bf16(float lo, float hi) { unsigned r; asm volatile("v_cvt_pk_bf16_f32 %0, %1, %2" : "=v"(r) : "v"(lo), "v"(hi)); return r; }
typedef float f32x2 __attribute__((ext_vector_type(2)));
__device__ __forceinline__ int bidx_of(int row) { return row < 8192 ? (row >> 11) : 4 + ((row - 8192) >> 3); }
__device__ __forceinline__ int pidx_of(int row) { return row < 8192 ? (row & 2047) : 2048 + (row & 7); }
__device__ __forceinline__ float silu_f(float x) { return x * __builtin_amdgcn_rcpf(1.0f + __builtin_amdgcn_exp2f(-1.4426950408889634f * x)); }
__device__ __forceinline__ u32x4 pack8(const f32x4 a, const f32x4 b) { u32x4 w; w.x = cvt_pk_bf16(a[0], a[1]); w.y = cvt_pk_bf16(a[2], a[3]); w.z = cvt_pk_bf16(b[0], b[1]); w.w = cvt_pk_bf16(b[2], b[3]); return w; }

struct EpiPlain {
    static constexpr bool PERM = true, AFTER_DRAIN = false;
    bf16_t* O; int ldc;
    __device__ __forceinline__ void operator()(const f32x4 (&acc)[2][2][4][2], const Unit& u, int wr, int wc, int fr, int fq) const {
        const int row0 = u.pm * BM + wr * 64 + fr, col0 = u.pn * BM + wc * 32 + 8 * fq;
#pragma unroll
        for (int ai = 0; ai < 2; ++ai)
#pragma unroll
            for (int m = 0; m < 4; ++m) { bf16_t* rowp = O + (size_t)(row0 + ai * HALF + m * 16) * ldc + col0;
#pragma unroll
                for (int bj = 0; bj < 2; ++bj) *(u32x4*)(rowp + bj * HALF) = pack8(acc[ai][bj][m][0], acc[ai][bj][m][1]); }
    }
};

struct EpiRetIn {
    static constexpr bool PERM = true, AFTER_DRAIN = false;
    bf16_t* O; const float* rt;
    __device__ __forceinline__ void operator()(const f32x4 (&acc)[2][2][4][2], const Unit& u, int wr, int wc, int fr, int fq) const {
        const int row0 = u.pm * BM + wr * 64 + fr, col0 = u.pn * BM + wc * 32 + 8 * fq;
        const int kind = u.pn < 16 ? 0 : (u.pn < 32 ? 1 : 2);
        const float ksc = (u.pn >= 8) ? 0.0625f : 1.0f;
#pragma unroll
        for (int ai = 0; ai < 2; ++ai)
#pragma unroll
            for (int m = 0; m < 4; ++m) {
                const int row = row0 + ai * HALF + m * 16; bf16_t* rowp = O + (size_t)row * 12288 + col0;
                f32x4 a0 = acc[ai][0][m][0], a1 = acc[ai][0][m][1], b0 = acc[ai][1][m][0], b1 = acc[ai][1][m][1];
                if (kind == 0) {
                    const float* tp = rt + ((size_t)pidx_of(row) * 128 + wc * 32 + 8 * fq) * 2;
                    const f32x4 t0 = *(const f32x4*)(tp), t1 = *(const f32x4*)(tp + 4), t2 = *(const f32x4*)(tp + 8), t3 = *(const f32x4*)(tp + 12);
                    f32x4 ra0, ra1, rb0, rb1;
                    ra0[0] = a0[0] * t0[0] - b0[0] * t0[1]; rb0[0] = b0[0] * t0[0] + a0[0] * t0[1];
                    ra0[1] = a0[1] * t0[2] - b0[1] * t0[3]; rb0[1] = b0[1] * t0[2] + a0[1] * t0[3];
                    ra0[2] = a0[2] * t1[0] - b0[2] * t1[1]; rb0[2] = b0[2] * t1[0] + a0[2] * t1[1];
                    ra0[3] = a0[3] * t1[2] - b0[3] * t1[3]; rb0[3] = b0[3] * t1[2] + a0[3] * t1[3];
                    ra1[0] = a1[0] * t2[0] - b1[0] * t2[1]; rb1[0] = b1[0] * t2[0] + a1[0] * t2[1];
                    ra1[1] = a1[1] * t2[2] - b1[1] * t2[3]; rb1[1] = b1[1] * t2[2] + a1[1] * t2[3];
                    ra1[2] = a1[2] * t3[0] - b1[2] * t3[1]; rb1[2] = b1[2] * t3[0] + a1[2] * t3[1];
                    ra1[3] = a1[3] * t3[2] - b1[3] * t3[3]; rb1[3] = b1[3] * t3[2] + a1[3] * t3[3];
                    a0 = ra0 * ksc; a1 = ra1 * ksc; b0 = rb0 * ksc; b1 = rb1 * ksc;
                } else if (kind == 2) {
#pragma unroll
                    for (int e = 0; e < 4; ++e) { a0[e] = silu_f(a0[e]); a1[e] = silu_f(a1[e]); b0[e] = silu_f(b0[e]); b1[e] = silu_f(b1[e]); }
                }
                *(u32x4*)(rowp) = pack8(a0, a1); *(u32x4*)(rowp + HALF) = pack8(b0, b1);
                if (m & 1) asm volatile("" ::: "memory");
            }
    }
};

struct EpiResid {
    static constexpr bool PERM = false, AFTER_DRAIN = false;
    float* X; const float* gate;
    __device__ __forceinline__ void operator()(const f32x4 (&acc)[2][2][4][2], const Unit& u, int wr, int wc, int fr, int fq) const {
        const int row0 = u.pm * BM + wr * 64 + fr, col0 = u.pn * BM + wc * 32 + 4 * fq;
#pragma unroll
        for (int ai = 0; ai < 2; ++ai)
#pragma unroll
            for (int m = 0; m < 4; ++m) {
                const int row = row0 + ai * HALF + m * 16; float* xr = X + (size_t)row * 2048 + col0; const float* gr = gate + (size_t)bidx_of(row) * 12288 + col0;
#pragma unroll
                for (int bj = 0; bj < 2; ++bj)
#pragma unroll
                    for (int n = 0; n < 2; ++n) { const f32x4 g4 = *(const f32x4*)(gr + bj * HALF + n * 16); f32x4 x4 = *(const f32x4*)(xr + bj * HALF + n * 16);
                        x4 = x4 + g4 * acc[ai][bj][m][n]; *(f32x4*)(xr + bj * HALF + n * 16) = x4; }
                if (m & 1) asm volatile("" ::: "memory");
            }
    }
};

struct EpiHead {
    static constexpr bool PERM = true, AFTER_DRAIN = false;
    bf16_t* O; int ldc; const float* rta;
    int rope_tiles;
    float* wk_p; float* wv_p; float* wk_s; float* wv_s;
    __device__ __forceinline__ void operator()(const f32x4 (&acc)[2][2][4][2], const Unit& u, int wr, int wc, int fr, int fq) const {
        const int row0 = u.pm * BM + wr * 64 + fr, col0 = u.pn * BM + wc * 32 + 8 * fq;
        const bool rope = (u.pn < rope_tiles) && ((wc & 1) == 0);
#pragma unroll
        for (int ai = 0; ai < 2; ++ai)
#pragma unroll
            for (int m = 0; m < 4; ++m) {
                const int row = row0 + ai * HALF + m * 16; bf16_t* rowp = O + (size_t)row * ldc + col0;
#pragma unroll
                for (int bj = 0; bj < 2; ++bj) {
                    f32x4 v0 = acc[ai][bj][m][0], v1 = acc[ai][bj][m][1];
                    if (rope) {
                        f32x4 p0, p1;
#pragma unroll
                        for (int e = 0; e < 4; ++e) { p0[e] = __shfl_xor(v0[e], 16); p1[e] = __shfl_xor(v1[e], 16); }
                        if (fq < 2) {
                            const float* tp = rta + (size_t)pidx_of(row) * 16;
                            const f32x4 t0 = *(const f32x4*)(tp), t1 = *(const f32x4*)(tp + 4), t2 = *(const f32x4*)(tp + 8), t3 = *(const f32x4*)(tp + 12);
                            const float sg = (fq == 0) ? -1.0f : 1.0f;
                            v0[0] = v0[0] * t0[0] + sg * p0[0] * t0[1]; v0[1] = v0[1] * t0[2] + sg * p0[1] * t0[3];
                            v0[2] = v0[2] * t1[0] + sg * p0[2] * t1[1]; v0[3] = v0[3] * t1[2] + sg * p0[3] * t1[3];
                            v1[0] = v1[0] * t2[0] + sg * p1[0] * t2[1]; v1[1] = v1[1] * t2[2] + sg * p1[1] * t2[3];
                            v1[2] = v1[2] * t3[0] + sg * p1[2] * t3[1]; v1[3] = v1[3] * t3[2] + sg * p1[3] * t3[3];
                        }
                    }
                    *(u32x4*)(rowp + bj * HALF) = pack8(v0, v1);
                    if (wk_p) {
                        const int c = wc * 32 + 8 * fq + bj * HALF; float* dst = nullptr;
                        if (row < 8192) { const int t = row & 2047; if (t >= 1920) dst = (u.pn == 0 ? wk_p : wv_p) + ((size_t)(row >> 11) * 128 + (t - 1920)) * 256 + c; }
                        else { const int sb = (row - 8192) >> 3, t = row & 7; dst = (u.pn == 0 ? wk_s : wv_s) + ((size_t)sb * 128 + 120 + t) * 256 + c; }
                        if (dst) { *(f32x4*)(dst) = v0; *(f32x4*)(dst + 4) = v1; }
                    }
                }
                if (m & 1) asm volatile("" ::: "memory");
            }
    }
};
template <class Epi, class Sched, bool ALIGN_EPI = false, bool SP2 = false>
__device__ __forceinline__ void gemm_phase(PG8_LAS unsigned char* lds, const Gemm g, const Sched& S, const Epi& E) {
    int tid_ = threadIdx.x; asm volatile("" : "+v"(tid_));
    const int tid = tid_, wid = __builtin_amdgcn_readfirstlane(tid >> 6), lane = tid & 63, wr = wid >> 2, wc = wid & 3, fr = lane & 15, fq = lane >> 4;
    const int K = g.K, nt = K / BK;
    unsigned voffA[2], voffB[2];
#pragma unroll
    for (int i = 0; i < 2; ++i) { int R, C; stage_rc(tid * 16 + i * 8192, R, C); const int Rb = Epi::PERM ? ((R & ~31) + perm32(R & 31)) : R;
        voffA[i] = (unsigned)(R * K + C) * 2u; voffB[i] = (unsigned)(Rb * K + C) * 2u; }
    const size_t kstep = (size_t)(BK * 2);
    const size_t hstep = (size_t)HALF * K * 2;
    const size_t tstep = 2 * hstep;
    const unsigned ldsw = (unsigned)wid * 1024u;
    const int aoff = lds_byte(wr * 64 + fr, fq * 8), boff = lds_byte(wc * 32 + fr, fq * 8);
#define PG8_SA(b, h) (((b) * 2 + (h)) * HTB)
#define PG8_SB(b, h) ((4 + (b) * 2 + (h)) * HTB)
#define PG8_STAGE(bufoff, gbase, voff) do { _Pragma("unroll") for (int _i = 0; _i < 2; ++_i) \
        __builtin_amdgcn_global_load_lds((const unsigned*)((const char*)(gbase) + (voff)[_i]), (PG8_LAS unsigned*)(lds + (bufoff) + ldsw + _i * 8192), 16, 0, 0); } while (0)
#define PG8_LDA(dst, b, h) do { _Pragma("unroll") for (int m = 0; m < 4; ++m) _Pragma("unroll") for (int k = 0; k < 2; ++k) dst[m][k] = *(const PG8_LAS bf16x8*)(lds + PG8_SA(b, h) + aoff + m * 2048 + k * 1024); } while (0)
#define PG8_LDB(dst, b, h) do { _Pragma("unroll") for (int n = 0; n < 2; ++n) _Pragma("unroll") for (int k = 0; k < 2; ++k) dst[n][k] = *(const PG8_LAS bf16x8*)(lds + PG8_SB(b, h) + boff + n * 2048 + k * 1024); } while (0)
#define PG8_MMA(ai, bj, At, Bt) do { __builtin_amdgcn_s_setprio(1); _Pragma("unroll") for (int m = 0; m < 4; ++m) _Pragma("unroll") for (int n = 0; n < 2; ++n) _Pragma("unroll") for (int k = 0; k < 2; ++k) \
        acc[ai][bj][m][n] = __builtin_amdgcn_mfma_f32_16x16x32_bf16(Bt[n][k], At[m][k], acc[ai][bj][m][n], 0, 0, 0); __builtin_amdgcn_s_setprio(0); } while (0)
#define PG8_WAIT_V(n) asm volatile("s_waitcnt vmcnt(" #n ")" ::: "memory")
#define PG8_WAIT_L(n) asm volatile("s_waitcnt lgkmcnt(" #n ")" ::: "memory")
#define PG8_BAR __builtin_amdgcn_s_barrier()
#define PG8_SCHED __builtin_amdgcn_sched_barrier(0)
    Unit cur, nxt; int ui = 0;
    if (!S.next(0, cur)) return;
    f32x4 acc[2][2][4][2];
#pragma unroll
    for (int a = 0; a < 2; ++a)
#pragma unroll
        for (int b = 0; b < 2; ++b)
#pragma unroll
            for (int m = 0; m < 4; ++m)
#pragma unroll
                for (int n = 0; n < 2; ++n) acc[a][b][m][n] = (f32x4){0.f, 0.f, 0.f, 0.f};
    bf16x8 At[4][2], B0[2][2], B1[2][2];
    const char* cA = (const char*)g.A + (size_t)cur.pm * tstep; const char* cB = (const char*)g.Bt + (size_t)cur.pn * tstep;
    S.a_ready(cur);
    if constexpr (SP2) {
        PG8_STAGE(PG8_SB(0, 0), cB, voffB); PG8_STAGE(PG8_SB(0, 1), cB + hstep, voffB); PG8_STAGE(PG8_SA(0, 0), cA, voffA); PG8_STAGE(PG8_SA(0, 1), cA + hstep, voffA);
        if (wr == 1) PG8_BAR;
        PG8_WAIT_V(2); PG8_BAR;
        PG8_STAGE(PG8_SB(1, 0), cB + kstep, voffB); PG8_STAGE(PG8_SA(1, 0), cA + kstep, voffA); PG8_STAGE(PG8_SB(1, 1), cB + hstep + kstep, voffB);
        PG8_WAIT_V(6); PG8_BAR;
    } else {
        PG8_STAGE(PG8_SB(0, 0), cB, voffB); PG8_STAGE(PG8_SA(0, 0), cA, voffA); PG8_STAGE(PG8_SB(0, 1), cB + hstep, voffB); PG8_STAGE(PG8_SA(0, 1), cA + hstep, voffA);
        if (wr == 1) PG8_BAR;
        PG8_WAIT_V(4); PG8_BAR;
        PG8_STAGE(PG8_SB(1, 0), cB + kstep, voffB); PG8_STAGE(PG8_SA(1, 0), cA + kstep, voffA); PG8_STAGE(PG8_SB(1, 1), cB + hstep + kstep, voffB);
        PG8_WAIT_V(6); PG8_BAR;
    }
    for (;;) {
        const bool has_next = S.next(ui + 1, nxt);
        const char* nA = has_next ? (const char*)g.A + (size_t)nxt.pm * tstep : cA; const char* nB = has_next ? (const char*)g.Bt + (size_t)nxt.pn * tstep : cB;
        for (int t = 0; t < nt; t += 2) {
            const bool last = (t == nt - 2);
            const char* a1 = cA + (size_t)(t + 1) * kstep;
            const char* a2 = last ? nA : cA + (size_t)(t + 2) * kstep; const char* b2 = last ? nB : cB + (size_t)(t + 2) * kstep;
            const char* a3 = a2 + kstep; const char* b3 = b2 + kstep;
            if (last && has_next) S.a_ready(nxt);
            if constexpr (SP2) {
            PG8_LDB(B0, 0, 0); PG8_LDB(B1, 0, 1); PG8_SCHED; PG8_LDA(At, 0, 0); PG8_STAGE(PG8_SA(1, 1), a1 + hstep, voffA);
            PG8_WAIT_V(8); PG8_WAIT_L(0); PG8_BAR; PG8_MMA(0, 0, At, B0); PG8_MMA(0, 1, At, B1); PG8_BAR; PG8_SCHED;
            PG8_LDA(At, 0, 1); PG8_STAGE(PG8_SB(0, 0), b2, voffB); PG8_STAGE(PG8_SB(0, 1), b2 + hstep, voffB); PG8_STAGE(PG8_SA(0, 0), a2, voffA);
            PG8_WAIT_V(8); PG8_WAIT_L(0); PG8_BAR; PG8_MMA(1, 0, At, B0); PG8_MMA(1, 1, At, B1); PG8_BAR; PG8_SCHED;
            PG8_LDB(B0, 1, 0); PG8_LDB(B1, 1, 1); PG8_SCHED; PG8_LDA(At, 1, 0); PG8_STAGE(PG8_SA(0, 1), a2 + hstep, voffA);
            PG8_WAIT_V(8); PG8_WAIT_L(0); PG8_BAR; PG8_MMA(0, 0, At, B0); PG8_MMA(0, 1, At, B1); PG8_BAR; PG8_SCHED;
            PG8_LDA(At, 1, 1); PG8_STAGE(PG8_SB(1, 0), b3, voffB); PG8_STAGE(PG8_SB(1, 1), b3 + hstep, voffB); PG8_STAGE(PG8_SA(1, 0), a3, voffA);
            PG8_WAIT_V(8); PG8_WAIT_L(0); PG8_BAR; PG8_MMA(1, 0, At, B0); PG8_MMA(1, 1, At, B1); PG8_BAR; PG8_SCHED;
            } else {
            PG8_LDB(B0, 0, 0); PG8_SCHED; PG8_LDA(At, 0, 0); PG8_STAGE(PG8_SA(1, 1), a1 + hstep, voffA);
            PG8_WAIT_L(8); PG8_BAR; PG8_WAIT_L(0); PG8_MMA(0, 0, At, B0); PG8_BAR; PG8_SCHED;
            PG8_LDB(B1, 0, 1); PG8_STAGE(PG8_SB(0, 0), b2, voffB);
            PG8_BAR; PG8_WAIT_L(0); PG8_MMA(0, 1, At, B1); PG8_BAR;
            PG8_LDA(At, 0, 1); PG8_STAGE(PG8_SA(0, 0), a2, voffA);
            PG8_BAR; PG8_WAIT_L(0); PG8_MMA(1, 0, At, B0); PG8_BAR; PG8_SCHED;
            PG8_STAGE(PG8_SB(0, 1), b2 + hstep, voffB);
            PG8_WAIT_V(6); PG8_BAR; PG8_MMA(1, 1, At, B1); PG8_BAR;
            PG8_LDB(B0, 1, 0); PG8_SCHED; PG8_LDA(At, 1, 0); PG8_STAGE(PG8_SA(0, 1), a2 + hstep, voffA);
            PG8_WAIT_L(8); PG8_BAR; PG8_WAIT_L(0); PG8_MMA(0, 0, At, B0); PG8_BAR; PG8_SCHED;
            PG8_LDB(B1, 1, 1); PG8_STAGE(PG8_SB(1, 0), b3, voffB);
            PG8_BAR; PG8_WAIT_L(0); PG8_MMA(0, 1, At, B1); PG8_BAR;
            PG8_LDA(At, 1, 1); PG8_STAGE(PG8_SA(1, 0), a3, voffA);
            PG8_BAR; PG8_WAIT_L(0); PG8_MMA(1, 0, At, B0); PG8_BAR; PG8_SCHED;
            PG8_STAGE(PG8_SB(1, 1), b3 + hstep, voffB);
            PG8_WAIT_V(6); PG8_BAR; PG8_MMA(1, 1, At, B1); PG8_BAR;
            }
        }
        if constexpr (ALIGN_EPI) { if (wr == 0) PG8_BAR; }
        if constexpr (!Epi::AFTER_DRAIN) { E(acc, cur, wr, wc, fr, fq); S.done(cur); }
        if (!has_next) break;
#pragma unroll
        for (int a = 0; a < 2; ++a)
#pragma unroll
            for (int b = 0; b < 2; ++b)
#pragma unroll
                for (int m = 0; m < 4; ++m)
#pragma unroll
                    for (int n = 0; n < 2; ++n) acc[a][b][m][n] = (f32x4){0.f, 0.f, 0.f, 0.f};
        cur = nxt; cA = nA; cB = nB; ++ui;
        if constexpr (ALIGN_EPI) { if (wr == 1) PG8_BAR; }
    }
    PG8_WAIT_V(0);
    if constexpr (!ALIGN_EPI) { if (wr == 0) PG8_BAR; }
    PG8_BAR;
    if constexpr (Epi::AFTER_DRAIN) { E.fused(acc, cur, wr, wc, fr, fq, lds, wid, lane); S.done(cur); }
#undef PG8_SA
#undef PG8_SB
#undef PG8_STAGE
#undef PG8_LDA
#undef PG8_LDB
#undef PG8_MMA
#undef PG8_WAIT_V
#undef PG8_WAIT_L
#undef PG8_BAR
#undef PG8_SCHED
}
}
#define GAS __attribute__((address_space(1)))
#define LAS __attribute__((address_space(3)))
typedef unsigned short bf16;
typedef unsigned v4u __attribute__((ext_vector_type(4)));
typedef float f32x4 __attribute__((ext_vector_type(4)));
typedef short bf16x8 __attribute__((ext_vector_type(8)));
typedef GAS unsigned gu32;
typedef GAS unsigned long long gu64;
#define RLX_AGENT __ATOMIC_RELAXED, __HIP_MEMORY_SCOPE_AGENT
#define LDS_WAIT() asm volatile("s_waitcnt lgkmcnt(0)" ::: "memory")
#define VM_WAIT() asm volatile("s_waitcnt vmcnt(0)" ::: "memory")
__device__ __forceinline__ unsigned long long rt() { return __builtin_amdgcn_s_memrealtime(); }
__device__ __forceinline__ unsigned f2bf(float f) { unsigned u = __builtin_bit_cast(unsigned, f); return (u + 0x7fffu + ((u >> 16) & 1u)) >> 16; }
__device__ __forceinline__ unsigned pk2(float lo, float hi) { return f2bf(lo) | (f2bf(hi) << 16); }

#define XB_TMO      128
#define XB_XCNT(j)  (256  + 64 * (j))
#define XB_XSUB(j)  (1280 + 64 * (j))
#define XB_XGEN(j)  (2304 + 64 * (j))
#define XB_TOP      3328
#define XB_TOPGEN   3392
#define XCD_BAR_WORDS 3456
#define XB_SPIN_CAP (1u << 18)

__device__ __forceinline__ unsigned xb_ld(unsigned* p)              { return __hip_atomic_load(p, __ATOMIC_RELAXED, __HIP_MEMORY_SCOPE_AGENT); }
__device__ __forceinline__ unsigned xb_add(unsigned* p, unsigned v) { return __hip_atomic_fetch_add(p, v, __ATOMIC_RELAXED, __HIP_MEMORY_SCOPE_AGENT); }
__device__ __forceinline__ unsigned xb_xcc_id() { return (unsigned)__builtin_amdgcn_s_getreg((3 << 11) | 20) & 0xFu; }
#define XB_SPIN(cond, bar) do { unsigned _sp = 0; while (cond) { __builtin_amdgcn_s_sleep(1); \
    if ((++_sp & 255u) == 0u) { if (xb_ld(&(bar)[XB_TMO])) break; if (_sp > XB_SPIN_CAP) { atomicAdd(&(bar)[XB_TMO], 1u); break; } } } } while (0)

struct XcdBarrier {
    unsigned* bar; unsigned x;
    volatile LAS unsigned* st;
};

__device__ __forceinline__ XcdBarrier xcd_barrier_post(unsigned* bar, volatile LAS unsigned* st) {
    XcdBarrier b; b.bar = bar; b.x = xb_xcc_id(); b.st = st;
    if (threadIdx.x == 0) (void)xb_add(&bar[XB_XCNT(b.x)], 1u);
    return b;
}
__device__ __forceinline__ void xcd_barrier_complete(unsigned* bar, unsigned x, unsigned& nloc, unsigned& nx) {
    const unsigned G = gridDim.x * gridDim.y * gridDim.z;
    unsigned sum, cnt, mine, sp = 0u;
    for (;;) {
        sum = 0u; cnt = 0u; mine = 0u;
#pragma unroll
        for (unsigned j = 0; j < 16; ++j) { const unsigned c = xb_ld(&bar[XB_XCNT(j)]); sum += c; cnt += (c > 0u) ? 1u : 0u; mine = (j == x) ? c : mine; }
        if (sum == G) break;
        __builtin_amdgcn_s_sleep(1);
        if ((++sp & 255u) == 0u) { if (xb_ld(&bar[XB_TMO])) break; if (sp > XB_SPIN_CAP) { atomicAdd(&bar[XB_TMO], 1u); break; } }
    }
    nloc = mine > 0u ? mine : 1u; nx = cnt > 0u ? cnt : 1u;
}

__device__ __forceinline__ void xcd_barrier(const XcdBarrier& b) {
    asm volatile("s_waitcnt vmcnt(0)" ::: "memory");
    __syncthreads();
    if (threadIdx.x == 0) {
        unsigned* bar = b.bar;
        __builtin_amdgcn_s_waitcnt(0);
        unsigned nloc = b.st[0], nx = b.st[1];
        if (nloc == 0u) { xcd_barrier_complete(bar, b.x, nloc, nx); b.st[0] = nloc; b.st[1] = nx; }
        const unsigned old = xb_add(&bar[XB_XSUB(b.x)], 1u);
        const unsigned gen = old / nloc;
        if (old + 1u == (gen + 1u) * nloc) {
            __builtin_amdgcn_fence(__ATOMIC_RELEASE, "agent");
            asm volatile("s_waitcnt vmcnt(0)" ::: "memory");
            const unsigned og = xb_add(&bar[XB_TOP], 1u);
            const unsigned tg = og / nx;
            if (og + 1u == (tg + 1u) * nx) xb_add(&bar[XB_TOPGEN], 1u);
            else XB_SPIN(xb_ld(&bar[XB_TOPGEN]) == tg, bar);
            __builtin_amdgcn_fence(__ATOMIC_ACQUIRE, "agent");
            xb_add(&bar[XB_XGEN(b.x)], 1u);
            asm volatile("s_waitcnt vmcnt(0)" ::: "memory");
        } else {
            XB_SPIN(xb_ld(&bar[XB_XGEN(b.x)]) == gen, bar);
            __builtin_amdgcn_fence(__ATOMIC_ACQUIRE, "agent");
            asm volatile("s_waitcnt vmcnt(0)" ::: "memory");
        }
    }
    __syncthreads();
}
__device__ __forceinline__ float wave_sum(float v) {
#pragma unroll
    for (int o = 1; o < 64; o <<= 1) v += __shfl_xor(v, o);
    return v;
}
__device__ __forceinline__ void p0_transpose_item(const float* W, int K, int N, bf16* WT, int row_off, LAS float* scr, int item, int lane) {
    const int nblk = N / 32, kb = item / nblk, nb = item % nblk, k0 = 64 * kb, n0 = 32 * nb;
#pragma unroll 8
    for (int i = 0; i < 32; ++i) { const int kk = 2 * i + (lane >> 5); scr[kk * 33 + (lane & 31)] = W[(size_t)(k0 + kk) * N + n0 + (lane & 31)]; }
    LDS_WAIT(); asm volatile("" ::: "memory");
    const int c = lane & 7;
#pragma unroll
    for (int j = 0; j < 4; ++j) { const int n = (lane >> 3) + 8 * j; const LAS float* s = scr + (8 * c) * 33 + n;
        v4u o; o.x = pk2(s[0 * 33], s[1 * 33]); o.y = pk2(s[2 * 33], s[3 * 33]); o.z = pk2(s[4 * 33], s[5 * 33]); o.w = pk2(s[6 * 33], s[7 * 33]);
        *(GAS v4u*)(WT + (size_t)(row_off + n0 + n) * K + k0 + 8 * c) = o; }
    LDS_WAIT(); asm volatile("" ::: "memory");
}

constexpr int NWAVES = 8;
constexpr int D = 2048, MP = 8192, MS = 256, MT = MP + MS, NMOD = 12288, NBM = 36;
constexpr int NQKVG = 12288, FF2 = 8192, DFF = 4096;
constexpr float EPS = 1e-6f;
constexpr size_t O_Y = 0, O_RETP = 17301504, O_RETS = 25690112, O_WKP = 92798976, O_WVP = 92930048, O_WKS = 93061120, O_WVS = 94109696, O_CONVP = 95158272, O_CONVS = 95420416, O_TOTAL = 97517568;
constexpr size_t MiB = 1u << 20;
constexpr size_t WS_CTL = 0, WS_MODS = 1 * MiB, WS_KVMODS = 8 * MiB, ZERO_BYTES = 9 * MiB;
constexpr size_t WS_RTR = 9 * MiB, WS_RTA = 12 * MiB;
constexpr size_t WS_X = 13 * MiB, WS_H = 79 * MiB, WS_HK = 112 * MiB, WS_QKVG = 145 * MiB, WS_U = 343 * MiB, WS_O = 475 * MiB, WS_A2 = 607 * MiB, WS_QA = 673 * MiB, WS_KV = 706 * MiB;
constexpr size_t WS_WIN = 715 * MiB, WS_WOUT = 811 * MiB, WS_WUP = 843 * MiB, WS_WDOWN = 971 * MiB, WS_WQ = 1035 * MiB, WS_WO = 1051 * MiB, WS_WKV = 1067 * MiB, WS_END = 1069 * MiB;
constexpr int CW_BAR = 4096;
constexpr int RING_BYTES = 131072, LDSCTL_OFF = RING_BYTES, MISC_OFF = LDSCTL_OFF + 320, LDS_BYTES = 147456;

struct Frame {
    LAS unsigned char* lds;
    volatile LAS unsigned* MISC;
    gu32* ctl;
    int tid, lane, wave, vcu, G;
    const float *x_prompt, *x_sample, *state_ret, *cache_k, *cache_v, *state_conv, *c_prompt, *c_sample, *w_ada, *b_ada, *norm_mix, *norm_ffn, *ret_w_in, *ret_gn, *ret_w_out,
                *kv_norm, *kv_w_ada, *kv_b_ada, *w_kv, *att_w_q, *att_sinks, *att_w_o, *ffn_w_up, *ffn_conv_w, *ffn_conv_b, *ffn_w_down, *norm_f;
    float* out;
    float *mods, *kvmods, *rtr, *rta, *X, *O;
    bf16 *H, *HK, *QKVG, *U, *A2, *QA, *KV, *WIN, *WOUT, *WUP, *WDOWN, *WQ, *WO, *WKV;
};
__device__ __forceinline__ unsigned cvtpk(float lo, float hi) { typedef float f32x2_t __attribute__((ext_vector_type(2))); typedef __bf16 bf16x2_t __attribute__((ext_vector_type(2)));
    f32x2_t v = {lo, hi}; bf16x2_t b = __builtin_convertvector(v, bf16x2_t); return __builtin_bit_cast(unsigned, b); }
__device__ __forceinline__ float bf2f(unsigned short h) { return __builtin_bit_cast(float, (unsigned)h << 16); }
__device__ __forceinline__ float bflo(unsigned w) { return __builtin_bit_cast(float, w << 16); }
__device__ __forceinline__ float bfhi(unsigned w) { return __builtin_bit_cast(float, w & 0xffff0000u); }
using pg8::bidx_of; using pg8::pidx_of;
typedef unsigned u32x2_t __attribute__((ext_vector_type(2)));

__device__ __forceinline__ double exp_neg(double x) {
    const double n = __builtin_rint(x * 1.4426950408889634);
    double r = __builtin_fma(-n, 0.6931471805599453, x); r = __builtin_fma(-n, 2.3190468138462996e-17, r);
    double t = 1.0, s = 1.0;
#pragma unroll
    for (int k = 1; k <= 16; ++k) { t *= -r / (double)k; s += t; }
    return __builtin_ldexp(s, -(int)n);
}
__device__ __forceinline__ void sincos_f32ang(float ang, float& c, float& s) {
    const double a = (double)ang, n = __builtin_rint(a * 0.15915494309189535);
    double r = __builtin_fma(-n, 6.283185307179586, a); r = __builtin_fma(-n, 2.4492935982947064e-16, r);
    const double q = r * 0.25, q2 = q * q;
    double cs = 1.0, sn = 1.0, tc = 1.0, ts = 1.0;
#pragma unroll
    for (int k = 1; k <= 10; ++k) { tc *= -q2 / (double)((2 * k - 1) * (2 * k)); ts *= -q2 / (double)((2 * k) * (2 * k + 1)); cs += tc; sn += ts; }
    sn *= q;
#pragma unroll
    for (int k = 0; k < 2; ++k) { const double c2 = 2.0 * cs * cs - 1.0, s2 = 2.0 * sn * cs; cs = c2; sn = s2; }
    c = (float)cs; s = (float)sn;
}
__device__ __forceinline__ void p0_mods(Frame& F) {
    {
        LAS float* cs = (LAS float*)F.lds;
        for (int it = blockIdx.x; it < 416; it += F.G) {
            const int cb = it >> 3, kc = it & 7, k0 = kc * 256;
            const float* W; const float* bias; float* outp; int N, nb;
            if (cb < 48) { const int l = cb / 12; nb = cb % 12; W = F.w_ada + (size_t)l * D * NMOD; bias = F.b_ada + l * NMOD; outp = F.mods + (size_t)l * NBM * NMOD; N = NMOD; }
            else { nb = cb - 48; W = F.kv_w_ada; bias = F.kv_b_ada; outp = F.kvmods; N = 4096; }
            __syncthreads();
            for (int e = F.tid; e < NBM * 256; e += NWAVES * 64) { const int b = e >> 8, kk = e & 255;
                const float c = (b < 4) ? F.c_prompt[b * D + k0 + kk] : F.c_sample[(b - 4) * D + k0 + kk]; cs[e] = c / (1.0f + expf(-c)); }
            __syncthreads();
            const int col = nb * 1024 + F.wave * 128 + F.lane * 2;
            typedef float f32x2 __attribute__((ext_vector_type(2)));
            f32x2 acc[NBM];
#pragma unroll
            for (int b = 0; b < NBM; ++b) acc[b] = (f32x2){0.f, 0.f};
            const float* wp = W + (size_t)k0 * N + col;
            for (int kk = 0; kk < 256; kk += 4) {
                const f32x2 w0 = *(const f32x2*)(wp + (size_t)(kk + 0) * N), w1 = *(const f32x2*)(wp + (size_t)(kk + 1) * N), w2 = *(const f32x2*)(wp + (size_t)(kk + 2) * N), w3 = *(const f32x2*)(wp + (size_t)(kk + 3) * N);
#pragma unroll
                for (int b = 0; b < NBM; ++b) { const f32x4 c4 = *(const LAS f32x4*)(cs + b * 256 + kk); acc[b] += w0 * c4[0] + w1 * c4[1] + w2 * c4[2] + w3 * c4[3]; if ((b & 7) == 7) __builtin_amdgcn_sched_barrier(0); }
            }
            f32x2 bv = (f32x2){0.f, 0.f}; if (kc == 0) bv = *(const f32x2*)(bias + col);
#pragma unroll
            for (int b = 0; b < NBM; ++b) { float* o = outp + (size_t)b * N + col;
                __hip_atomic_fetch_add(o, acc[b][0] + bv[0], __ATOMIC_RELAXED, __HIP_MEMORY_SCOPE_AGENT); __hip_atomic_fetch_add(o + 1, acc[b][1] + bv[1], __ATOMIC_RELAXED, __HIP_MEMORY_SCOPE_AGENT); }
        }
        __syncthreads();
    }
}
__device__ __forceinline__ void p0_weights(Frame& F) {
    const int gw = F.vcu * NWAVES + F.wave, NGW = F.G * NWAVES;
    {
        LAS float* scr = (LAS float*)(F.lds + F.wave * 16384);
        constexpr int I_IN = 32 * 384, I_OUT = 64 * 64, I_KV = 32 * 16, I_Q = 32 * 64, I_UP = 32 * 256, I_DN = 64 * 64;
        constexpr int E0 = 2 * I_IN, E1 = E0 + 2 * I_OUT, E2 = E1 + I_KV, E3 = E2 + 2 * I_Q, E4 = E3 + 2 * I_Q, E5 = E4 + 4 * I_UP, E6 = E5 + 4 * I_DN;
        for (int it = gw; it < E6; it += NGW) {
            const float* W; bf16* WT; int K, N, r;
            if (it < E0)      { const int l = it / I_IN; r = it % I_IN; W = F.ret_w_in + (size_t)l * 2048 * 12288; WT = F.WIN + (size_t)l * 12288 * 2048; K = 2048; N = 12288; }
            else if (it < E1) { const int q = it - E0, l = q / I_OUT; r = q % I_OUT; W = F.ret_w_out + (size_t)l * 4096 * 2048; WT = F.WOUT + (size_t)l * 2048 * 4096; K = 4096; N = 2048; }
            else if (it < E2) { r = it - E1; W = F.w_kv; WT = F.WKV; K = 2048; N = 512; }
            else if (it < E3) { const int q = it - E2, l = q / I_Q; r = q % I_Q; W = F.att_w_q + (size_t)l * 2048 * 2048; WT = F.WQ + (size_t)l * 2048 * 2048; K = 2048; N = 2048; }
            else if (it < E4) { const int q = it - E3, l = q / I_Q; r = q % I_Q; W = F.att_w_o + (size_t)l * 2048 * 2048; WT = F.WO + (size_t)l * 2048 * 2048; K = 2048; N = 2048; }
            else if (it < E5) { const int q = it - E4, l = q / I_UP; r = q % I_UP; W = F.ffn_w_up + (size_t)l * 2048 * 8192; WT = F.WUP + (size_t)l * 8192 * 2048; K = 2048; N = 8192; }
            else              { const int q = it - E5, l = q / I_DN; r = q % I_DN; W = F.ffn_w_down + (size_t)l * 4096 * 2048; WT = F.WDOWN + (size_t)l * 2048 * 4096; K = 4096; N = 2048; }
            p0_transpose_item(W, K, N, WT, 0, scr, r, F.lane);
        }
    }
}
__device__ __forceinline__ void p0_tables(Frame& F) {
    const int gw = F.vcu * NWAVES + F.wave, NGW = F.G * NWAVES, gt = gw * 64 + F.lane, NGT = NGW * 64;
    for (int e = gt; e < 2056 * 136; e += NGT) {
        const int p = e / 136, i = e % 136; const float pos = (float)(p < 2048 ? p : 16384 + (p - 2048));
        float c, s;
        if (i < 128) { const float inv = (float)exp_neg((double)i * (9.210340371976184 / 128.0)); sincos_f32ang(pos * inv, c, s); F.rtr[((size_t)p * 128 + i) * 2] = c; F.rtr[((size_t)p * 128 + i) * 2 + 1] = s; }
        else { const int j = i - 128; const float inv = (float)exp_neg((double)j * (13.122363377404328 / 8.0)); sincos_f32ang(pos * inv, c, s); F.rta[((size_t)p * 8 + j) * 2] = c; F.rta[((size_t)p * 8 + j) * 2 + 1] = s; }
    }
}
__device__ __forceinline__ void p0_copies(Frame& F) {
    const int gw = F.vcu * NWAVES + F.wave, NGW = F.G * NWAVES, gt = gw * 64 + F.lane, NGT = NGW * 64;
    for (int e = gt; e < MT * D / 4; e += NGT) { const int pe = MP * D / 4;
        const f32x4 v = e < pe ? ((const f32x4*)F.x_prompt)[e] : ((const f32x4*)F.x_sample)[e - pe]; ((f32x4*)F.X)[e] = v; }
    for (int e = gt; e < 32 * 120 * 64; e += NGT) { const int sb = e / (120 * 64), r = e % (120 * 64);
        ((f32x4*)(F.out + O_WKS))[(size_t)sb * 128 * 64 + r] = ((const f32x4*)F.cache_k)[(size_t)sb * 128 * 64 + 8 * 64 + r];
        ((f32x4*)(F.out + O_WVS))[(size_t)sb * 128 * 64 + r] = ((const f32x4*)F.cache_v)[(size_t)sb * 128 * 64 + 8 * 64 + r]; }
}

__device__ __forceinline__ void t_norm_mod(Frame& F, const float* gv, const float* sh, const float* sc, int mstride, bf16* outp,
                                           const float* gv2, const float* sh2, const float* sc2, int mstride2, bf16* outp2) {
    const int gw = F.vcu * NWAVES + F.wave, NGW = F.G * NWAVES;
    for (int row = gw; row < MT; row += NGW) {
        const float* xr = F.X + (size_t)row * D + 4 * F.lane;
        f32x4 v[8]; float ss = 0.f;
#pragma unroll
        for (int j = 0; j < 8; ++j) { v[j] = *(const f32x4*)(xr + 256 * j); ss += (v[j][0] * v[j][0] + v[j][1] * v[j][1]) + (v[j][2] * v[j][2] + v[j][3] * v[j][3]); }
        const float rstd = 1.0f / sqrtf(wave_sum(ss) * (1.0f / D) + EPS);
        const int b = bidx_of(row);
#pragma unroll
        for (int j = 0; j < 8; ++j) { const int c = 4 * F.lane + 256 * j;
            const f32x4 g4 = *(const f32x4*)(gv + c), s4 = *(const f32x4*)(sc + (size_t)b * mstride + c), h4 = *(const f32x4*)(sh + (size_t)b * mstride + c);
            const f32x4 o = v[j] * rstd * g4 * (s4 + 1.0f) + h4;
            typedef unsigned u32x2 __attribute__((ext_vector_type(2)));
            u32x2 w; w.x = cvtpk(o[0], o[1]); w.y = cvtpk(o[2], o[3]); *(u32x2*)(outp + (size_t)row * D + c) = w; }
        if (gv2) {
#pragma unroll
            for (int j = 0; j < 8; ++j) { const int c = 4 * F.lane + 256 * j;
                const f32x4 g4 = *(const f32x4*)(gv2 + c), s4 = *(const f32x4*)(sc2 + (size_t)b * mstride2 + c), h4 = *(const f32x4*)(sh2 + (size_t)b * mstride2 + c);
                const f32x4 o = v[j] * rstd * g4 * (s4 + 1.0f) + h4;
                typedef unsigned u32x2 __attribute__((ext_vector_type(2)));
                u32x2 w; w.x = cvtpk(o[0], o[1]); w.y = cvtpk(o[2], o[3]); *(u32x2*)(outp2 + (size_t)row * D + c) = w; }
        }
    }
}
__device__ __forceinline__ void t_final_norm(Frame& F) {
    const int gw = F.vcu * NWAVES + F.wave, NGW = F.G * NWAVES;
    for (int row = gw; row < MT; row += NGW) {
        const float* xr = F.X + (size_t)row * D + 4 * F.lane;
        f32x4 v[8]; float ss = 0.f;
#pragma unroll
        for (int j = 0; j < 8; ++j) { v[j] = *(const f32x4*)(xr + 256 * j); ss += (v[j][0] * v[j][0] + v[j][1] * v[j][1]) + (v[j][2] * v[j][2] + v[j][3] * v[j][3]); }
        const float rstd = 1.0f / sqrtf(wave_sum(ss) * (1.0f / D) + EPS);
#pragma unroll
        for (int j = 0; j < 8; ++j) { const int c = 4 * F.lane + 256 * j; *(f32x4*)(F.out + O_Y + (size_t)row * D + c) = v[j] * rstd * *(const f32x4*)(F.norm_f + c); }
    }
}
__device__ __forceinline__ void t_gn_gate(Frame& F, int l) {
    const int gw = F.vcu * NWAVES + F.wave, NGW = F.G * NWAVES;
    const float* gn = F.ret_gn + (size_t)l * 4096;
    for (int it = gw; it < MT * 8; it += NGW) {
        const int row = it >> 3, h = it & 7, c = h * 512 + 8 * F.lane;
        const float* op = F.O + (size_t)row * 4096 + c;
        const f32x4 o0 = *(const f32x4*)(op), o1 = *(const f32x4*)(op + 4);
        const v4u gq = *(const v4u*)(F.QKVG + (size_t)row * NQKVG + 8192 + c);
        const f32x4 g0 = *(const f32x4*)(gn + c), g1 = *(const f32x4*)(gn + c + 4);
        const float mu = wave_sum((o0[0] + o0[1]) + (o0[2] + o0[3]) + (o1[0] + o1[1]) + (o1[2] + o1[3])) * (1.0f / 512.0f);
        const f32x4 d0 = o0 - mu, d1 = o1 - mu;
        const float var = wave_sum((d0[0] * d0[0] + d0[1] * d0[1]) + (d0[2] * d0[2] + d0[3] * d0[3]) + (d1[0] * d1[0] + d1[1] * d1[1]) + (d1[2] * d1[2] + d1[3] * d1[3])) * (1.0f / 512.0f);
        const float rstd = 1.0f / sqrtf(var + EPS);
        const f32x4 y0 = d0 * rstd * g0, y1 = d1 * rstd * g1;
        v4u w;
        w.x = cvtpk(bflo(gq.x) * y0[0], bfhi(gq.x) * y0[1]); w.y = cvtpk(bflo(gq.y) * y0[2], bfhi(gq.y) * y0[3]);
        w.z = cvtpk(bflo(gq.z) * y1[0], bfhi(gq.z) * y1[1]); w.w = cvtpk(bflo(gq.w) * y1[2], bfhi(gq.w) * y1[3]);
        *(v4u*)(F.A2 + (size_t)row * 4096 + c) = w;
    }
}
__device__ __forceinline__ void t_conv_gate(Frame& F, int l) {
    const int gw = F.vcu * NWAVES + F.wave, NGW = F.G * NWAVES;
    const float* cw = F.ffn_conv_w + (size_t)l * 3 * FF2; const float* cbv = F.ffn_conv_b + (size_t)l * FF2;
    for (int it = gw; it < (MT / 8) * 8; it += NGW) {
        const int run = it >> 3, cc = it & 7, r0 = run * 8, j0 = cc * 512 + 8 * F.lane;
        float pa2[8], pa1[8], pb2[8], pb1[8];
        const bool sample = r0 >= MP; const int t0 = sample ? 0 : (r0 & 2047);
        if (sample) {
            const float* sp = F.state_conv + ((size_t)(l * 32 + ((r0 - MP) >> 3)) * 2) * FF2;
#pragma unroll
            for (int e = 0; e < 8; ++e) { pa2[e] = sp[j0 + e]; pb2[e] = sp[4096 + j0 + e]; pa1[e] = sp[FF2 + j0 + e]; pb1[e] = sp[FF2 + 4096 + j0 + e]; }
        } else if (t0 == 0) {
#pragma unroll
            for (int e = 0; e < 8; ++e) { pa2[e] = 0.f; pb2[e] = 0.f; pa1[e] = 0.f; pb1[e] = 0.f; }
        } else {
            const v4u a2 = *(const v4u*)(F.U + (size_t)(r0 - 2) * FF2 + j0), b2 = *(const v4u*)(F.U + (size_t)(r0 - 2) * FF2 + 4096 + j0);
            const v4u a1 = *(const v4u*)(F.U + (size_t)(r0 - 1) * FF2 + j0), b1 = *(const v4u*)(F.U + (size_t)(r0 - 1) * FF2 + 4096 + j0);
#pragma unroll
            for (int q = 0; q < 4; ++q) { pa2[2 * q] = bflo(a2[q]); pa2[2 * q + 1] = bfhi(a2[q]); pb2[2 * q] = bflo(b2[q]); pb2[2 * q + 1] = bfhi(b2[q]);
                                          pa1[2 * q] = bflo(a1[q]); pa1[2 * q + 1] = bfhi(a1[q]); pb1[2 * q] = bflo(b1[q]); pb1[2 * q + 1] = bfhi(b1[q]); }
        }
        float wa[3][8], wb[3][8], ba[8], bb[8];
#pragma unroll
        for (int i = 0; i < 3; ++i) { const f32x4 x0 = *(const f32x4*)(cw + i * FF2 + j0), x1 = *(const f32x4*)(cw + i * FF2 + j0 + 4), y0 = *(const f32x4*)(cw + i * FF2 + 4096 + j0), y1 = *(const f32x4*)(cw + i * FF2 + 4096 + j0 + 4);
#pragma unroll
            for (int e = 0; e < 4; ++e) { wa[i][e] = x0[e]; wa[i][4 + e] = x1[e]; wb[i][e] = y0[e]; wb[i][4 + e] = y1[e]; } }
        { const f32x4 x0 = *(const f32x4*)(cbv + j0), x1 = *(const f32x4*)(cbv + j0 + 4), y0 = *(const f32x4*)(cbv + 4096 + j0), y1 = *(const f32x4*)(cbv + 4096 + j0 + 4);
#pragma unroll
            for (int e = 0; e < 4; ++e) { ba[e] = x0[e]; ba[4 + e] = x1[e]; bb[e] = y0[e]; bb[4 + e] = y1[e]; } }
        float* cst = nullptr;
        if (sample) cst = F.out + O_CONVS + ((size_t)(l * 32 + ((r0 - MP) >> 3)) * 2) * FF2;
        else if (t0 == 2040) cst = F.out + O_CONVP + ((size_t)(l * 4 + (r0 >> 11)) * 2) * FF2;
#pragma unroll
        for (int t = 0; t < 8; ++t) {
            const v4u ua = *(const v4u*)(F.U + (size_t)(r0 + t) * FF2 + j0), ub = *(const v4u*)(F.U + (size_t)(r0 + t) * FF2 + 4096 + j0);
            float ca[8], cb2[8], act[8];
#pragma unroll
            for (int q = 0; q < 4; ++q) { ca[2 * q] = bflo(ua[q]); ca[2 * q + 1] = bfhi(ua[q]); cb2[2 * q] = bflo(ub[q]); cb2[2 * q + 1] = bfhi(ub[q]); }
#pragma unroll
            for (int e = 0; e < 8; ++e) {
                const float za = ba[e] + wa[0][e] * pa2[e] + wa[1][e] * pa1[e] + wa[2][e] * ca[e];
                const float zb = bb[e] + wb[0][e] * pb2[e] + wb[1][e] * pb1[e] + wb[2][e] * cb2[e];
                act[e] = pg8::silu_f(za) * zb;
                pa2[e] = pa1[e]; pa1[e] = ca[e]; pb2[e] = pb1[e]; pb1[e] = cb2[e];
            }
            v4u w; w.x = cvtpk(act[0], act[1]); w.y = cvtpk(act[2], act[3]); w.z = cvtpk(act[4], act[5]); w.w = cvtpk(act[6], act[7]);
            *(v4u*)(F.A2 + (size_t)(r0 + t) * DFF + j0) = w;
            if (cst && t >= 6) { float* d = cst + (size_t)(t - 6) * FF2;
                *(f32x4*)(d + j0) = (f32x4){ca[0], ca[1], ca[2], ca[3]}; *(f32x4*)(d + j0 + 4) = (f32x4){ca[4], ca[5], ca[6], ca[7]};
                *(f32x4*)(d + 4096 + j0) = (f32x4){cb2[0], cb2[1], cb2[2], cb2[3]}; *(f32x4*)(d + 4096 + j0 + 4) = (f32x4){cb2[4], cb2[5], cb2[6], cb2[7]}; }
        }
    }
}

constexpr int SM_STG_BYTES = 13824, SM_T_OFF = 8 * SM_STG_BYTES, SM_T_LD = 68, SM_ROWB = 144;
static_assert(SM_T_OFF + 32 * SM_T_LD * 4 <= RING_BYTES, "small-GEMM LDS");
template <class Epi>
__device__ __forceinline__ void gemm_small(Frame& F, const bf16* A, const bf16* Bt, int N, int K, const Epi& E) {
    LAS unsigned char* stg = F.lds + F.wave * SM_STG_BYTES;
    LAS float* red = (LAS float*)stg;
    LAS float* T = (LAS float*)(F.lds + SM_T_OFF);
    const int w = F.wave, lane = F.lane, fr = lane & 15, g = lane >> 4, tid = F.tid;
    const int ntn = N >> 6, nunits = 8 * ntn, kslice = K >> 3, nch = kslice >> 6;
    const int lrow = lane >> 3, lpc = lane & 7;
    for (int u = F.vcu; u < nunits; u += F.G) {
        const int rt8 = u & 7, ctile = u >> 3, r0 = rt8 * 32;
        int cb[4]; E.cols(ctile, cb);
        const bf16* src[12];
#pragma unroll
        for (int i = 0; i < 4; ++i) src[i] = A + (size_t)(r0 + 8 * i + lrow) * K + w * kslice + 8 * lpc;
#pragma unroll
        for (int i = 0; i < 8; ++i) src[4 + i] = Bt + (size_t)(cb[i >> 1] + 8 * (i & 1) + lrow) * K + w * kslice + 8 * lpc;
        f32x4 acc[2][4];
#pragma unroll
        for (int a = 0; a < 2; ++a)
#pragma unroll
            for (int c = 0; c < 4; ++c) acc[a][c] = (f32x4){0.f, 0.f, 0.f, 0.f};
        v4u pre[12];
#pragma unroll
        for (int i = 0; i < 12; ++i) pre[i] = *(const v4u*)(src[i]);
        __syncthreads();
        for (int ch = 0; ch < nch; ++ch) {
#pragma unroll
            for (int i = 0; i < 12; ++i) *(LAS v4u*)(stg + (8 * i + lrow) * SM_ROWB + lpc * 16) = pre[i];
            if (ch + 1 < nch) {
#pragma unroll
                for (int i = 0; i < 12; ++i) pre[i] = *(const v4u*)(src[i] + (ch + 1) * 64);
            }
#pragma unroll
            for (int s = 0; s < 2; ++s) {
                bf16x8 af[2], bfr[4];
#pragma unroll
                for (int a = 0; a < 2; ++a) af[a] = *(const LAS bf16x8*)(stg + (16 * a + fr) * SM_ROWB + (32 * s + 8 * g) * 2);
#pragma unroll
                for (int c = 0; c < 4; ++c) bfr[c] = *(const LAS bf16x8*)(stg + (32 + 16 * c + fr) * SM_ROWB + (32 * s + 8 * g) * 2);
#pragma unroll
                for (int a = 0; a < 2; ++a)
#pragma unroll
                    for (int c = 0; c < 4; ++c) acc[a][c] = __builtin_amdgcn_mfma_f32_16x16x32_bf16(af[a], bfr[c], acc[a][c], 0, 0, 0);
            }
        }
#pragma unroll
        for (int a = 0; a < 2; ++a)
#pragma unroll
            for (int c = 0; c < 4; ++c)
#pragma unroll
                for (int i = 0; i < 4; ++i) red[(16 * a + 4 * g + i) * 64 + 16 * c + fr] = acc[a][c][i];
        __syncthreads();
        const int row = tid >> 4, c4 = (tid & 15) * 4;
        f32x4 v = *(const LAS f32x4*)((LAS float*)(F.lds) + row * 64 + c4);
#pragma unroll
        for (int ww = 1; ww < 8; ++ww) v += *(const LAS f32x4*)((LAS float*)(F.lds + ww * SM_STG_BYTES) + row * 64 + c4);
        *(LAS f32x4*)(T + row * SM_T_LD + c4) = v;
        __syncthreads();
        E.apply(F, T, ctile, r0, row, c4);
    }
    __syncthreads();
}
__device__ __forceinline__ void st_bf16x4(bf16* p, float a, float b, float c, float d) { u32x2_t w; w.x = cvtpk(a, b); w.y = cvtpk(c, d); *(u32x2_t*)p = w; }

struct SEpiRetIn {
    __device__ __forceinline__ void cols(int ct, int (&cb)[4]) const {
        if (ct < 64) { const int hd = ct >> 2, qq = ct & 3, c0 = hd * 256 + 32 * qq; cb[0] = c0; cb[1] = c0 + 16; cb[2] = c0 + 128; cb[3] = c0 + 144; }
        else { const int c0 = 4096 + 64 * (ct - 64); cb[0] = c0; cb[1] = c0 + 16; cb[2] = c0 + 32; cb[3] = c0 + 48; }
    }
    __device__ __forceinline__ void apply(Frame& F, LAS float* T, int ct, int r0, int row, int c4) const {
        const int grow = MP + r0 + row; const LAS float* tr = T + row * SM_T_LD;
        const f32x4 v = *(const LAS f32x4*)(tr + c4);
        if (ct < 64) {
            const int hd = ct >> 2, qq = ct & 3; const bool hi = c4 >= 32; const int jj = hi ? c4 - 32 : c4, i0 = 32 * qq + jj;
            const f32x4 p = *(const LAS f32x4*)(tr + (hi ? c4 - 32 : c4 + 32));
            const float* tp = F.rtr + ((size_t)pidx_of(grow) * 128 + i0) * 2;
            const f32x4 t0 = *(const f32x4*)(tp), t1 = *(const f32x4*)(tp + 4);
            const float sc = (hd >= 8) ? 0.0625f : 1.0f, sg = hi ? 1.0f : -1.0f;
            const float o0 = (v[0] * t0[0] + sg * p[0] * t0[1]) * sc, o1 = (v[1] * t0[2] + sg * p[1] * t0[3]) * sc, o2 = (v[2] * t1[0] + sg * p[2] * t1[1]) * sc, o3 = (v[3] * t1[2] + sg * p[3] * t1[3]) * sc;
            st_bf16x4(F.QKVG + (size_t)grow * NQKVG + hd * 256 + (hi ? 128 : 0) + i0, o0, o1, o2, o3);
        } else {
            const int col = 4096 + 64 * (ct - 64) + c4;
            if (col >= 8192) st_bf16x4(F.QKVG + (size_t)grow * NQKVG + col, pg8::silu_f(v[0]), pg8::silu_f(v[1]), pg8::silu_f(v[2]), pg8::silu_f(v[3]));
            else st_bf16x4(F.QKVG + (size_t)grow * NQKVG + col, v[0], v[1], v[2], v[3]);
        }
    }
};
struct SEpiPlain {
    bf16* O; int ldc;
    __device__ __forceinline__ void cols(int ct, int (&cb)[4]) const { cb[0] = 64 * ct; cb[1] = 64 * ct + 16; cb[2] = 64 * ct + 32; cb[3] = 64 * ct + 48; }
    __device__ __forceinline__ void apply(Frame& F, LAS float* T, int ct, int r0, int row, int c4) const {
        const f32x4 v = *(const LAS f32x4*)(T + row * SM_T_LD + c4); st_bf16x4(O + (size_t)(MP + r0 + row) * ldc + 64 * ct + c4, v[0], v[1], v[2], v[3]); }
};
struct SEpiResid {
    const float* gate;
    __device__ __forceinline__ void cols(int ct, int (&cb)[4]) const { cb[0] = 64 * ct; cb[1] = 64 * ct + 16; cb[2] = 64 * ct + 32; cb[3] = 64 * ct + 48; }
    __device__ __forceinline__ void apply(Frame& F, LAS float* T, int ct, int r0, int row, int c4) const {
        const int grow = MP + r0 + row, col = 64 * ct + c4; const f32x4 v = *(const LAS f32x4*)(T + row * SM_T_LD + c4);
        const f32x4 g4 = *(const f32x4*)(gate + (size_t)bidx_of(grow) * NMOD + col); float* xp = F.X + (size_t)grow * D + col;
        *(f32x4*)xp = *(const f32x4*)xp + g4 * v; }
};
struct SEpiHead {
    bf16* O; int ldc, rope_tiles; float* wk_s; float* wv_s;
    __device__ __forceinline__ void cols(int ct, int (&cb)[4]) const { cb[0] = 64 * ct; cb[1] = 64 * ct + 16; cb[2] = 64 * ct + 32; cb[3] = 64 * ct + 48; }
    __device__ __forceinline__ void apply(Frame& F, LAS float* T, int ct, int r0, int row, int c4) const {
        const int grow = MP + r0 + row; const LAS float* tr = T + row * SM_T_LD; f32x4 v = *(const LAS f32x4*)(tr + c4);
        if (ct < rope_tiles && c4 < 16) {
            const bool hi = c4 >= 8; const f32x4 p = *(const LAS f32x4*)(tr + (hi ? c4 - 8 : c4 + 8)); const int i0 = hi ? c4 - 8 : c4;
            const float* tp = F.rta + ((size_t)pidx_of(grow) * 8 + i0) * 2; const f32x4 t0 = *(const f32x4*)(tp), t1 = *(const f32x4*)(tp + 4); const float sg = hi ? 1.0f : -1.0f;
            v = (f32x4){v[0] * t0[0] + sg * p[0] * t0[1], v[1] * t0[2] + sg * p[1] * t0[3], v[2] * t1[0] + sg * p[2] * t1[1], v[3] * t1[2] + sg * p[3] * t1[3]};
        }
        st_bf16x4(O + (size_t)grow * ldc + 64 * ct + c4, v[0], v[1], v[2], v[3]);
        if (wk_s) { const int sb = (r0 + row) >> 3, t = row & 7, col = 64 * ct + c4;
            float* dst = (col < 256 ? wk_s + col : wv_s + (col - 256)) + ((size_t)sb * 128 + 120 + t) * 256; *(f32x4*)dst = v; }
    }
};

__device__ __forceinline__ void ret_prompt_phase(Frame& F, int l) {
    LAS unsigned char* L = F.lds;
    constexpr int KS_STRIDE = 528, VT_STRIDE = 272, ST_STRIDE = 528, KS_OFF = 0, VT_OFF = 128 * KS_STRIDE, ST_OFF = VT_OFF + 64 * VT_STRIDE;
    static_assert(ST_OFF + 64 * ST_STRIDE <= RING_BYTES, "retention LDS");
    const int w = F.wave, lane = F.lane, fr = lane & 15, g = lane >> 4, tid = F.tid;
    const int rb = (w < 4) ? w : 11 - w;
    for (int unit = F.vcu; unit < 256; unit += F.G) {
        const int eb = unit & 7, h = (unit >> 3) & 7, b = unit >> 6;
        const float lg = log2f(1.0f - exp2f(-5.0f - (float)h));
        const float g128 = exp2f(128.0f * lg);
        f32x4 Sacc[2][4];
#pragma unroll
        for (int a = 0; a < 2; ++a)
#pragma unroll
            for (int e = 0; e < 4; ++e) Sacc[a][e] = (f32x4){0.f, 0.f, 0.f, 0.f};
        const bf16* Qh = F.QKVG + h * 256; const bf16* Kh = F.QKVG + 2048 + h * 256; const bf16* Vh = F.QKVG + 4096 + h * 512 + eb * 64;
        for (int c = 0; c < 16; ++c) {
            const size_t r0 = (size_t)b * 2048 + 128 * c;
            v4u kreg[8], vreg[2]; bf16x8 qf[8];
#pragma unroll
            for (int i = 0; i < 8; ++i) { const int p = tid + 512 * i; kreg[i] = *(const v4u*)(Kh + (r0 + (p >> 5)) * NQKVG + (p & 31) * 8); }
#pragma unroll
            for (int i = 0; i < 2; ++i) { const int p = tid + 512 * i; vreg[i] = *(const v4u*)(Vh + (r0 + (p & 127)) * NQKVG + (p >> 7) * 8); }
#pragma unroll
            for (int ks = 0; ks < 8; ++ks) qf[ks] = *(const bf16x8*)(Qh + (r0 + 16 * rb + fr) * NQKVG + 32 * ks + 8 * g);
            __syncthreads();
#pragma unroll
            for (int i = 0; i < 8; ++i) { const int p = tid + 512 * i; *(LAS v4u*)(L + KS_OFF + (p >> 5) * KS_STRIDE + (p & 31) * 16) = kreg[i]; }
#pragma unroll
            for (int i = 0; i < 2; ++i) { const int p = tid + 512 * i, m = p & 127, e8 = (p >> 7) * 8; const float kd = exp2f((float)(127 - m) * lg);
#pragma unroll
                for (int q = 0; q < 4; ++q) { const unsigned pk = cvtpk(bflo(vreg[i][q]) * kd, bfhi(vreg[i][q]) * kd);
                    *(LAS unsigned short*)(L + VT_OFF + (e8 + 2 * q) * VT_STRIDE + m * 2) = (unsigned short)(pk & 0xffffu);
                    *(LAS unsigned short*)(L + VT_OFF + (e8 + 2 * q + 1) * VT_STRIDE + m * 2) = (unsigned short)(pk >> 16); } }
#pragma unroll
            for (int dt = 0; dt < 2; ++dt)
#pragma unroll
                for (int et = 0; et < 4; ++et) { Sacc[dt][et] = Sacc[dt][et] * g128;
                    u32x2_t sw; sw.x = cvtpk(Sacc[dt][et][0], Sacc[dt][et][1]); sw.y = cvtpk(Sacc[dt][et][2], Sacc[dt][et][3]);
                    *(LAS u32x2_t*)(L + ST_OFF + (16 * et + fr) * ST_STRIDE + (32 * w + 16 * dt + 4 * g) * 2) = sw; }
            __syncthreads();
            f32x4 P[8];
#pragma unroll
            for (int t = 0; t < 8; ++t) {
                P[t] = (f32x4){0.f, 0.f, 0.f, 0.f};
                if (t <= rb) {
#pragma unroll
                    for (int ks = 0; ks < 8; ++ks) { const bf16x8 kf = *(const LAS bf16x8*)(L + KS_OFF + (16 * t + fr) * KS_STRIDE + (32 * ks + 8 * g) * 2);
                        P[t] = __builtin_amdgcn_mfma_f32_16x16x32_bf16(kf, qf[ks], P[t], 0, 0, 0); }
                    if (t == rb) {
#pragma unroll
                        for (int i = 0; i < 4; ++i) if (4 * g + i > fr) P[t][i] = 0.f;
                    }
                }
            }
            bf16x8 pa[4];
#pragma unroll
            for (int tp = 0; tp < 4; ++tp) { v4u pw; pw.x = cvtpk(P[2 * tp][0], P[2 * tp][1]); pw.y = cvtpk(P[2 * tp][2], P[2 * tp][3]); pw.z = cvtpk(P[2 * tp + 1][0], P[2 * tp + 1][1]); pw.w = cvtpk(P[2 * tp + 1][2], P[2 * tp + 1][3]);
                pa[tp] = __builtin_bit_cast(bf16x8, pw); }
            const float arow = exp2f((float)(16 * rb + fr - 127) * lg);
            float* orow = F.O + (r0 + 16 * rb + fr) * 4096 + h * 512 + eb * 64 + 4 * g;
#pragma unroll
            for (int et = 0; et < 4; ++et) {
                f32x4 oacc = (f32x4){0.f, 0.f, 0.f, 0.f};
#pragma unroll
                for (int tp = 0; tp < 4; ++tp) if (2 * tp <= rb) {
                    const LAS unsigned char* vp = L + VT_OFF + (16 * et + fr) * VT_STRIDE + (32 * tp + 4 * g) * 2;
                    const u32x2_t v0 = *(const LAS u32x2_t*)(vp), v1 = *(const LAS u32x2_t*)(vp + 32);
                    const v4u vv = (v4u){v0.x, v0.y, v1.x, v1.y};
                    oacc = __builtin_amdgcn_mfma_f32_16x16x32_bf16(__builtin_bit_cast(bf16x8, vv), pa[tp], oacc, 0, 0, 0); }
#pragma unroll
                for (int ks = 0; ks < 8; ++ks) { const bf16x8 sf = *(const LAS bf16x8*)(L + ST_OFF + (16 * et + fr) * ST_STRIDE + (32 * ks + 8 * g) * 2);
                    oacc = __builtin_amdgcn_mfma_f32_16x16x32_bf16(sf, qf[ks], oacc, 0, 0, 0); }
                *(f32x4*)(orow + 16 * et) = oacc * arow;
            }
#pragma unroll
            for (int tp = 0; tp < 4; ++tp) {
                bf16x8 vf[4];
#pragma unroll
                for (int et = 0; et < 4; ++et) { const LAS unsigned char* vp = L + VT_OFF + (16 * et + fr) * VT_STRIDE + (32 * tp + 4 * g) * 2;
                    const u32x2_t v0 = *(const LAS u32x2_t*)(vp), v1 = *(const LAS u32x2_t*)(vp + 32); const v4u vv = (v4u){v0.x, v0.y, v1.x, v1.y}; vf[et] = __builtin_bit_cast(bf16x8, vv); }
#pragma unroll
                for (int dt = 0; dt < 2; ++dt) {
                    const LAS unsigned char* kp = L + KS_OFF + (32 * tp + 4 * g) * KS_STRIDE + (32 * w + 16 * dt + fr) * 2;
                    unsigned short kk[8];
#pragma unroll
                    for (int j = 0; j < 4; ++j) { kk[j] = *(const LAS unsigned short*)(kp + j * KS_STRIDE); kk[4 + j] = *(const LAS unsigned short*)(kp + (16 + j) * KS_STRIDE); }
                    v4u kw; kw.x = (unsigned)kk[0] | ((unsigned)kk[1] << 16); kw.y = (unsigned)kk[2] | ((unsigned)kk[3] << 16); kw.z = (unsigned)kk[4] | ((unsigned)kk[5] << 16); kw.w = (unsigned)kk[6] | ((unsigned)kk[7] << 16);
                    const bf16x8 ktf = __builtin_bit_cast(bf16x8, kw);
#pragma unroll
                    for (int et = 0; et < 4; ++et) Sacc[dt][et] = __builtin_amdgcn_mfma_f32_16x16x32_bf16(ktf, vf[et], Sacc[dt][et], 0, 0, 0);
                }
            }
        }
        float* sp = F.out + O_RETP + ((size_t)((l * 4 + b) * 8 + h) * 256) * 512 + eb * 64;
#pragma unroll
        for (int dt = 0; dt < 2; ++dt)
#pragma unroll
            for (int et = 0; et < 4; ++et)
#pragma unroll
                for (int i = 0; i < 4; ++i) sp[(size_t)(32 * w + 16 * dt + 4 * g + i) * 512 + 16 * et + fr] = Sacc[dt][et][i];
    }
}

__device__ __forceinline__ void ret_sample_phase(Frame& F, int l) {
    LAS float* Lq = (LAS float*)F.lds;
    LAS float* Lk = Lq + 2048;
    LAS float* Lt = Lk + 2048;
    LAS float* La = Lt + 4096;
    LAS float* Lr = La + 64;
    const int tid = F.tid, e4 = tid & 127, dq = tid >> 7, e = 4 * e4;
    for (int unit = F.vcu; unit < 256; unit += F.G) {
        const int sb = unit >> 3, h = unit & 7;
        const float lg = log2f(1.0f - exp2f(-5.0f - (float)h));
        const size_t r0 = (size_t)MP + 8 * sb;
        __syncthreads();
        for (int i = tid; i < 4096; i += 512) { const int which = i >> 11, t = (i >> 8) & 7, d = i & 255;
            const float v = bf2f(F.QKVG[(r0 + t) * NQKVG + which * 2048 + h * 256 + d]); (which ? Lk : Lq)[t * 256 + d] = v; }
        __syncthreads();
        if (tid < 64) { const int t = tid >> 3, m = tid & 7; float s = 0.f;
            for (int d = 0; d < 256; ++d) s += Lq[t * 256 + d] * Lk[m * 256 + d];
            La[tid] = (m <= t) ? s * exp2f((float)(t - m) * lg) : 0.f; }
        for (int i = tid; i < 4096; i += 512) { const int d = i >> 4, j = i & 15;
            Lt[i] = (j < 8) ? Lq[j * 256 + d] * exp2f((float)(j + 1) * lg) : Lk[(j - 8) * 256 + d] * exp2f((float)(15 - j) * lg); }
        f32x4 vv[8];
#pragma unroll
        for (int m = 0; m < 8; ++m) { typedef unsigned u32x2 __attribute__((ext_vector_type(2)));
            const u32x2 q = *(const u32x2*)(F.QKVG + (r0 + m) * NQKVG + 4096 + h * 512 + e); vv[m] = (f32x4){bflo(q.x), bfhi(q.x), bflo(q.y), bfhi(q.y)}; }
        __syncthreads();
        const float g8 = exp2f(8.0f * lg);
        const float* Sin = F.state_ret + ((size_t)((l * 32 + sb) * 8 + h) * 256) * 512 + e;
        float* Sout = F.out + O_RETS + ((size_t)((l * 32 + sb) * 8 + h) * 256) * 512 + e;
        f32x4 oacc[8];
#pragma unroll
        for (int t = 0; t < 8; ++t) oacc[t] = (f32x4){0.f, 0.f, 0.f, 0.f};
        for (int i0 = 0; i0 < 64; i0 += 4) {
            f32x4 s[4];
#pragma unroll
            for (int u = 0; u < 4; ++u) s[u] = *(const f32x4*)(Sin + (size_t)(4 * (i0 + u) + dq) * 512);
#pragma unroll
            for (int u = 0; u < 4; ++u) { const int d = 4 * (i0 + u) + dq;
                const f32x4 q0 = *(const LAS f32x4*)(Lt + d * 16), q1 = *(const LAS f32x4*)(Lt + d * 16 + 4), k0 = *(const LAS f32x4*)(Lt + d * 16 + 8), k1 = *(const LAS f32x4*)(Lt + d * 16 + 12);
#pragma unroll
                for (int t = 0; t < 4; ++t) { oacc[t] += s[u] * q0[t]; oacc[4 + t] += s[u] * q1[t]; }
                f32x4 sn = s[u] * g8;
#pragma unroll
                for (int m = 0; m < 4; ++m) { sn += vv[m] * k0[m]; sn += vv[4 + m] * k1[m]; }
                *(f32x4*)(Sout + (size_t)d * 512) = sn; }
        }
#pragma unroll
        for (int t = 0; t < 8; ++t) *(LAS f32x4*)(Lr + (dq * 8 + t) * 512 + e) = oacc[t];
        __syncthreads();
#pragma unroll
        for (int tt = 0; tt < 2; ++tt) { const int t = 2 * dq + tt;
            f32x4 o = *(const LAS f32x4*)(Lr + (0 * 8 + t) * 512 + e) + *(const LAS f32x4*)(Lr + (1 * 8 + t) * 512 + e) + *(const LAS f32x4*)(Lr + (2 * 8 + t) * 512 + e) + *(const LAS f32x4*)(Lr + (3 * 8 + t) * 512 + e);
#pragma unroll
            for (int m = 0; m < 8; ++m) o += vv[m] * La[t * 8 + m];
            *(f32x4*)(F.O + (r0 + t) * 4096 + h * 512 + e) = o; }
    }
}

__device__ __forceinline__ void attn_prompt_phase(Frame& F, int j) {
    LAS unsigned char* L = F.lds;
    constexpr int KB_STRIDE = 144, VT_STRIDE = 528, KB_OFF = 0, VT_OFF = 256 * KB_STRIDE;
    static_assert(VT_OFF + 64 * VT_STRIDE <= RING_BYTES, "attention LDS");
    const int w = F.wave, lane = F.lane, fr = lane & 15, g = lane >> 4, tid = F.tid;
    for (int unit = F.vcu; unit < 256; unit += F.G) {
        const int qblk = unit & 15, kvh = (unit >> 4) & 3, b = unit >> 6, hq = kvh * 8 + w;
        const float sink = F.att_sinks[j * 32 + hq];
        const size_t rowb = (size_t)b * 2048; const int q0 = qblk * 128;
        __syncthreads();
#pragma unroll
        for (int i = 0; i < 4; ++i) { const int p = tid + 512 * i, kk = p >> 3, c8 = (p & 7) * 8, pos = q0 - 128 + kk;
            v4u kv = (v4u){0u, 0u, 0u, 0u}; if (pos >= 0) kv = *(const v4u*)(F.KV + (rowb + pos) * 512 + kvh * 64 + c8);
            *(LAS v4u*)(L + KB_OFF + kk * KB_STRIDE + c8 * 2) = kv; }
#pragma unroll
        for (int i = 0; i < 4; ++i) { const int p = tid + 512 * i, kk = p & 255, c8 = (p >> 8) * 8, pos = q0 - 128 + kk;
            v4u vv = (v4u){0u, 0u, 0u, 0u}; if (pos >= 0) vv = *(const v4u*)(F.KV + (rowb + pos) * 512 + 256 + kvh * 64 + c8);
#pragma unroll
            for (int q = 0; q < 4; ++q) { *(LAS unsigned short*)(L + VT_OFF + (c8 + 2 * q) * VT_STRIDE + kk * 2) = (unsigned short)(vv[q] & 0xffffu);
                                          *(LAS unsigned short*)(L + VT_OFF + (c8 + 2 * q + 1) * VT_STRIDE + kk * 2) = (unsigned short)(vv[q] >> 16); } }
        __syncthreads();
        for (int rbk = 0; rbk < 8; ++rbk) {
            const size_t qrow = rowb + q0 + 16 * rbk + fr;
            bf16x8 qf[2];
#pragma unroll
            for (int ks = 0; ks < 2; ++ks) qf[ks] = *(const bf16x8*)(F.QA + qrow * 2048 + hq * 64 + 32 * ks + 8 * g);
            f32x4 S[10]; float mx = sink;
#pragma unroll
            for (int tl = 0; tl < 9; ++tl) {
                f32x4 s = (f32x4){0.f, 0.f, 0.f, 0.f};
#pragma unroll
                for (int ks = 0; ks < 2; ++ks) { const bf16x8 kf = *(const LAS bf16x8*)(L + KB_OFF + (16 * (rbk + tl) + fr) * KB_STRIDE + (32 * ks + 8 * g) * 2);
                    s = __builtin_amdgcn_mfma_f32_16x16x32_bf16(kf, qf[ks], s, 0, 0, 0); }
#pragma unroll
                for (int i = 0; i < 4; ++i) { const int rel = 128 - 16 * tl + fr - (4 * g + i); const int kpos = q0 - 128 + 16 * (rbk + tl) + 4 * g + i;
                    const bool ok = (rel >= 0) && (rel <= 128) && (kpos >= 0);
                    s[i] = ok ? s[i] * 0.125f : -1e30f; mx = fmaxf(mx, s[i]); }
                S[tl] = s;
            }
            mx = fmaxf(mx, __shfl_xor(mx, 16)); mx = fmaxf(mx, __shfl_xor(mx, 32));
            float den = 0.f;
#pragma unroll
            for (int tl = 0; tl < 9; ++tl)
#pragma unroll
                for (int i = 0; i < 4; ++i) { const float p = __expf(S[tl][i] - mx); S[tl][i] = p; den += p; }
            S[9] = (f32x4){0.f, 0.f, 0.f, 0.f};
            den += __shfl_xor(den, 16); den += __shfl_xor(den, 32);
            den += __expf(sink - mx);
            const float rden = 1.0f / den;
            bf16* orow = F.A2 + qrow * 2048 + hq * 64 + 4 * g;
#pragma unroll
            for (int dt = 0; dt < 4; ++dt) {
                f32x4 oacc = (f32x4){0.f, 0.f, 0.f, 0.f};
#pragma unroll
                for (int tp = 0; tp < 5; ++tp) {
                    v4u pw; pw.x = cvtpk(S[2 * tp][0], S[2 * tp][1]); pw.y = cvtpk(S[2 * tp][2], S[2 * tp][3]); pw.z = cvtpk(S[2 * tp + 1][0], S[2 * tp + 1][1]); pw.w = cvtpk(S[2 * tp + 1][2], S[2 * tp + 1][3]);
                    const int k0 = 16 * (rbk + 2 * tp) + 4 * g; int k1 = k0 + 16; if (k1 > 252) k1 = 252;
                    const u32x2_t v0 = *(const LAS u32x2_t*)(L + VT_OFF + (16 * dt + fr) * VT_STRIDE + k0 * 2), v1 = *(const LAS u32x2_t*)(L + VT_OFF + (16 * dt + fr) * VT_STRIDE + k1 * 2);
                    const v4u vv = (v4u){v0.x, v0.y, v1.x, v1.y};
                    oacc = __builtin_amdgcn_mfma_f32_16x16x32_bf16(__builtin_bit_cast(bf16x8, vv), __builtin_bit_cast(bf16x8, pw), oacc, 0, 0, 0);
                }
                u32x2_t ow; ow.x = cvtpk(oacc[0] * rden, oacc[1] * rden); ow.y = cvtpk(oacc[2] * rden, oacc[3] * rden);
                *(u32x2_t*)(orow + 16 * dt) = ow;
            }
        }
    }
}

__device__ __forceinline__ void attn_sample_phase(Frame& F, int j) {
    LAS float* Kc = (LAS float*)F.lds;
    LAS float* Vc = Kc + 136 * 65;
    LAS float* Pw = Vc + 136 * 65 + F.wave * 192;
    const int w = F.wave, lane = F.lane, tid = F.tid;
    for (int unit = F.vcu; unit < 128; unit += F.G) {
        const int sb = unit >> 2, kvh = unit & 3, hq = kvh * 8 + w;
        const float sink = F.att_sinks[j * 32 + hq];
        const size_t r0 = (size_t)MP + 8 * sb;
        __syncthreads();
        for (int i = tid; i < 136 * 64; i += 512) { const int kk = i >> 6, d = i & 63; float kv, vv;
            if (kk < 128) { kv = F.cache_k[((size_t)(sb * 128 + kk) * 4 + kvh) * 64 + d]; vv = F.cache_v[((size_t)(sb * 128 + kk) * 4 + kvh) * 64 + d]; }
            else { kv = bf2f(F.KV[(r0 + kk - 128) * 512 + kvh * 64 + d]); vv = bf2f(F.KV[(r0 + kk - 128) * 512 + 256 + kvh * 64 + d]); }
            Kc[kk * 65 + d] = kv; Vc[kk * 65 + d] = vv; }
        __syncthreads();
        for (int t = 0; t < 8; ++t) {
            const float qv = bf2f(F.QA[(r0 + t) * 2048 + hq * 64 + lane]);
            float s0 = 0.f, s1 = 0.f, s2 = 0.f; const int k2 = (lane < 8) ? 128 + lane : 135;
            for (int d = 0; d < 64; ++d) { const float qd = __shfl(qv, d); s0 += qd * Kc[lane * 65 + d]; s1 += qd * Kc[(64 + lane) * 65 + d]; s2 += qd * Kc[k2 * 65 + d]; }
            const bool ok0 = lane >= t, ok1 = true, ok2 = (lane < 8) && (lane <= t);
            s0 = ok0 ? s0 * 0.125f : -1e30f; s1 = ok1 ? s1 * 0.125f : -1e30f; s2 = ok2 ? s2 * 0.125f : -1e30f;
            float mx = fmaxf(fmaxf(s0, s1), fmaxf(s2, sink));
#pragma unroll
            for (int o = 1; o < 64; o <<= 1) mx = fmaxf(mx, __shfl_xor(mx, o));
            const float p0 = __expf(s0 - mx), p1 = __expf(s1 - mx), p2 = (lane < 8) ? __expf(s2 - mx) : 0.f;
            const float den = wave_sum(p0 + p1 + p2) + __expf(sink - mx);
            Pw[lane] = p0; Pw[64 + lane] = p1; if (lane < 8) Pw[128 + lane] = p2;
            LDS_WAIT(); asm volatile("" ::: "memory");
            float o = 0.f;
            for (int kk = 0; kk < 136; ++kk) o += Pw[kk] * Vc[kk * 65 + lane];
            F.A2[(r0 + t) * 2048 + hq * 64 + lane] = (bf16)(cvtpk(o / den, 0.f) & 0xffffu);
            LDS_WAIT(); asm volatile("" ::: "memory");
        }
    }
}

#ifndef MK_MULTI
#define MK_MULTI 0
#endif
constexpr int N_PHASES = 36;

__device__ __forceinline__ void frame_refresh(Frame& F) {
    extern __shared__ __attribute__((aligned(16))) unsigned char lds[];
    int t_ = threadIdx.x; asm volatile("" : "+v"(t_));
    F.tid = t_; F.lane = t_ & 63; F.wave = __builtin_amdgcn_readfirstlane(t_ >> 6);
    F.lds = (LAS unsigned char*)lds;
    F.MISC = (volatile LAS unsigned*)(F.lds + MISC_OFF);
    const __attribute__((address_space(4))) unsigned char* ka = (const __attribute__((address_space(4))) unsigned char*)__builtin_amdgcn_kernarg_segment_ptr();
    asm volatile("" : "+s"(ka));
#define KIN(k) (*(const float* const __attribute__((address_space(4)))*)(ka + 8 * (k)))
    F.x_prompt = KIN(0); F.x_sample = KIN(1); F.state_ret = KIN(2); F.cache_k = KIN(3); F.cache_v = KIN(4); F.state_conv = KIN(5); F.c_prompt = KIN(6); F.c_sample = KIN(7);
    F.w_ada = KIN(8); F.b_ada = KIN(9); F.norm_mix = KIN(10); F.norm_ffn = KIN(11); F.ret_w_in = KIN(12); F.ret_gn = KIN(13); F.ret_w_out = KIN(14);
    F.kv_norm = KIN(15); F.kv_w_ada = KIN(16); F.kv_b_ada = KIN(17); F.w_kv = KIN(18); F.att_w_q = KIN(19); F.att_sinks = KIN(20); F.att_w_o = KIN(21);
    F.ffn_w_up = KIN(22); F.ffn_conv_w = KIN(23); F.ffn_conv_b = KIN(24); F.ffn_w_down = KIN(25); F.norm_f = KIN(26);
    F.out = (float*)KIN(27);
    unsigned char* ws = (unsigned char*)KIN(28);
#undef KIN
    F.ctl = (gu32*)(ws + WS_CTL);
    F.mods = (float*)(ws + WS_MODS); F.kvmods = (float*)(ws + WS_KVMODS); F.rtr = (float*)(ws + WS_RTR); F.rta = (float*)(ws + WS_RTA); F.X = (float*)(ws + WS_X); F.O = (float*)(ws + WS_O);
    F.H = (bf16*)(ws + WS_H); F.HK = (bf16*)(ws + WS_HK); F.QKVG = (bf16*)(ws + WS_QKVG); F.U = (bf16*)(ws + WS_U); F.A2 = (bf16*)(ws + WS_A2); F.QA = (bf16*)(ws + WS_QA); F.KV = (bf16*)(ws + WS_KV);
    F.WIN = (bf16*)(ws + WS_WIN); F.WOUT = (bf16*)(ws + WS_WOUT); F.WUP = (bf16*)(ws + WS_WUP); F.WDOWN = (bf16*)(ws + WS_WDOWN); F.WQ = (bf16*)(ws + WS_WQ); F.WO = (bf16*)(ws + WS_WO); F.WKV = (bf16*)(ws + WS_WKV);
}
struct Args { const float* in[27]; float* out; unsigned char* ws; int ph_lo, ph_hi, use_bar, pad; };
__global__ void __launch_bounds__(NWAVES * 64, 2) yoco_fwd(Args args) {
    extern __shared__ __attribute__((aligned(16))) unsigned char lds[];
    Frame F;
    F.G = gridDim.x; { const int bx = blockIdx.x; F.vcu = (F.G % 8 == 0) ? (bx % 8) * (F.G / 8) + bx / 8 : bx; }
    frame_refresh(F);
    for (int u = F.tid; u < (LDS_BYTES - LDSCTL_OFF) / 4; u += NWAVES * 64) ((LAS unsigned*)(F.lds + LDSCTL_OFF))[u] = 0u;
    __syncthreads();
    XcdBarrier bar; bar.bar = (unsigned*)(args.ws + WS_CTL) + CW_BAR; bar.x = 0; bar.st = (volatile LAS unsigned*)(F.lds + MISC_OFF) + 8;
    if (args.use_bar) bar = xcd_barrier_post(bar.bar, bar.st);
    const int lo = args.ph_lo, hi = args.ph_hi;
    int ph = 0;
#ifndef EN_MASK
#define EN_MASK 0xffffffffu
#endif
#define EN(k) ((EN_MASK >> (k)) & 1u)
#ifndef PROBE_MASK
#define PROBE_MASK 0u
#endif
#ifndef PROBE_AMP
#define PROBE_AMP 2
#endif
#define P_T0() unsigned long long pt0_ = 0; if (PROBE_MASK) pt0_ = __builtin_amdgcn_s_memrealtime()
#define P_T1(k) do { if ((PROBE_MASK >> (k)) & 1u) { __syncthreads(); if (threadIdx.x == 0) { const unsigned long long t1_ = __builtin_amdgcn_s_memrealtime(), d_ = (t1_ - pt0_) * PROBE_AMP; \
        while (__builtin_amdgcn_s_memrealtime() - t1_ < d_) __builtin_amdgcn_s_sleep(8); } __syncthreads(); pt0_ = __builtin_amdgcn_s_memrealtime(); } } while (0)
#define PH_ON ((ph >= lo && ph < hi) && (frame_refresh(F), true))
#define PH_END do { if (ph >= lo && ph + 1 < hi) xcd_barrier(bar); ++ph; } while (0)

    if (PH_ON && EN(0)) { P_T0(); p0_mods(F); P_T1(15); frame_refresh(F); p0_weights(F); P_T1(16); frame_refresh(F); p0_tables(F); frame_refresh(F); p0_copies(F); P_T1(0); }
    PH_END;

    for (int l = 0; l < 4; ++l) {
        #define md (F.mods + (size_t)l * NBM * NMOD)
        if (PH_ON && EN(1)) { P_T0();
            if (l == 2) t_norm_mod(F, F.norm_mix + l * D, md, md + D, NMOD, F.H, F.kv_norm, F.kvmods, F.kvmods + D, 4096, F.HK);
            else        t_norm_mod(F, F.norm_mix + l * D, md, md + D, NMOD, F.H, nullptr, nullptr, nullptr, 0, nullptr);
        P_T1(1); }
        PH_END;
        if (l < 2) {
            if (PH_ON && EN(2)) { P_T0(); pg8::Gemm g{F.H, F.WIN + (size_t)l * NQKVG * D, MP, NQKVG, D}; pg8::StaticOrder S; S.init(MP, NQKVG, F.G, (int)blockIdx.x);
                pg8::EpiRetIn E{F.QKVG, F.rtr};
                pg8::gemm_phase<pg8::EpiRetIn, pg8::StaticOrder, true, true>(F.lds, g, S, E);
                P_T1(2); frame_refresh(F); gemm_small(F, F.H + (size_t)MP * D, F.WIN + (size_t)l * NQKVG * D, NQKVG, D, SEpiRetIn{}); P_T1(17); }
            PH_END;
            if (PH_ON) { P_T0(); if (EN(3)) ret_prompt_phase(F, l); P_T1(3); if (EN(4)) ret_sample_phase(F, l); P_T1(4); }
            PH_END;
            if (PH_ON && EN(5)) { P_T0(); t_gn_gate(F, l); P_T1(5); }
            PH_END;
        } else {
            const int j = l - 2;
            if (PH_ON && EN(6)) { P_T0();
                { pg8::Gemm g{F.H, F.WQ + (size_t)j * D * D, MP, D, D}; pg8::StaticOrder S; S.init(MP, D, F.G, (int)blockIdx.x);
                  pg8::EpiHead E{F.QA, D, F.rta, 8, nullptr, nullptr, nullptr, nullptr};
                  pg8::gemm_phase<pg8::EpiHead, pg8::StaticOrder, true, true>(F.lds, g, S, E); }
                P_T1(6); frame_refresh(F); gemm_small(F, F.H + (size_t)MP * D, F.WQ + (size_t)j * D * D, D, D, SEpiHead{F.QA, D, 32, nullptr, nullptr}); P_T1(17);
                if (l == 2) { pg8::Gemm g{F.HK, F.WKV, MP, 512, D}; pg8::StaticOrder S; S.init(MP, 512, F.G, (int)blockIdx.x);
                  pg8::EpiHead E{F.KV, 512, F.rta, 1, F.out + O_WKP, F.out + O_WVP, F.out + O_WKS, F.out + O_WVS};
                  pg8::gemm_phase<pg8::EpiHead, pg8::StaticOrder, true, true>(F.lds, g, S, E);
                  P_T1(6); frame_refresh(F); gemm_small(F, F.HK + (size_t)MP * D, F.WKV, 512, D, SEpiHead{F.KV, 512, 4, F.out + O_WKS, F.out + O_WVS}); }
            P_T1(17); }
            PH_END;
            if (PH_ON) { P_T0(); if (EN(7)) attn_prompt_phase(F, j); P_T1(7); if (EN(8)) attn_sample_phase(F, j); P_T1(8); }
            PH_END;
        }
        if (PH_ON && EN(9)) { P_T0();
            const bf16* Bt = (l < 2) ? F.WOUT + (size_t)l * D * 4096 : F.WO + (size_t)(l - 2) * D * D; const int K = (l < 2) ? 4096 : D;
            pg8::Gemm g{F.A2, Bt, MP, D, K}; pg8::StaticOrder S; S.init(MP, D, F.G, (int)blockIdx.x);
            pg8::EpiResid E{F.X, md + 2 * D};
            pg8::gemm_phase<pg8::EpiResid, pg8::StaticOrder, true, true>(F.lds, g, S, E);
            P_T1(9); frame_refresh(F); gemm_small(F, F.A2 + (size_t)MP * K, (l < 2) ? F.WOUT + (size_t)l * D * 4096 : F.WO + (size_t)(l - 2) * D * D, D, K, SEpiResid{md + 2 * D});
        P_T1(17); }
        PH_END;
        if (PH_ON && EN(10)) { P_T0(); t_norm_mod(F, F.norm_ffn + l * D, md + 3 * D, md + 4 * D, NMOD, F.H, nullptr, nullptr, nullptr, 0, nullptr); P_T1(10); }
        PH_END;
        if (PH_ON && EN(11)) { P_T0(); pg8::Gemm g{F.H, F.WUP + (size_t)l * FF2 * D, MP, FF2, D}; pg8::StaticOrder S; S.init(MP, FF2, F.G, (int)blockIdx.x);
            pg8::EpiPlain E{F.U, FF2};
            pg8::gemm_phase<pg8::EpiPlain, pg8::StaticOrder, true, true>(F.lds, g, S, E);
            P_T1(11); frame_refresh(F); gemm_small(F, F.H + (size_t)MP * D, F.WUP + (size_t)l * FF2 * D, FF2, D, SEpiPlain{F.U, FF2}); P_T1(17); }
        PH_END;
        if (PH_ON && EN(12)) { P_T0(); t_conv_gate(F, l); P_T1(12); }
        PH_END;
        if (PH_ON && EN(13)) { P_T0(); pg8::Gemm g{F.A2, F.WDOWN + (size_t)l * D * DFF, MP, D, DFF}; pg8::StaticOrder S; S.init(MP, D, F.G, (int)blockIdx.x);
            pg8::EpiResid E{F.X, md + 5 * D};
            pg8::gemm_phase<pg8::EpiResid, pg8::StaticOrder, true, true>(F.lds, g, S, E);
            P_T1(13); frame_refresh(F); gemm_small(F, F.A2 + (size_t)MP * DFF, F.WDOWN + (size_t)l * D * DFF, D, DFF, SEpiResid{md + 5 * D}); P_T1(17); }
        PH_END;
    }
    if (PH_ON && EN(14)) { P_T0(); t_final_norm(F); P_T1(14); }
#undef md
#undef PH_ON
#undef PH_END
}

extern "C" void kernel_launch(void* const* d_in, const int* in_sizes, int n_in, void* d_out, int out_size, void* d_ws, size_t ws_size, hipStream_t stream) {
    static int grid = 0;
    if (grid == 0) {
        if (n_in != 27 || (size_t)out_size != O_TOTAL || ws_size < WS_END) { fprintf(stderr, "kernel_launch: unexpected problem: n_in %d out %d ws %zu (need 27, %zu, >= %zu); nothing launched\n", n_in, out_size, ws_size, (size_t)O_TOTAL, (size_t)WS_END); grid = -1; return; }
        int dev = 0, cus = 0, per_cu = 0;
        if (hipGetDevice(&dev) != hipSuccess || hipDeviceGetAttribute(&cus, hipDeviceAttributeMultiprocessorCount, dev) != hipSuccess) { fprintf(stderr, "kernel_launch: device query failed\n"); grid = -1; return; }
        if (hipFuncSetAttribute((const void*)yoco_fwd, hipFuncAttributeMaxDynamicSharedMemorySize, LDS_BYTES) != hipSuccess) { fprintf(stderr, "kernel_launch: hipFuncSetAttribute failed\n"); grid = -1; return; }
        if (hipOccupancyMaxActiveBlocksPerMultiprocessor(&per_cu, (const void*)yoco_fwd, NWAVES * 64, LDS_BYTES) != hipSuccess || per_cu < 1)
            fprintf(stderr, "kernel_launch: note: occupancy query reports %d workgroups per CU\n", per_cu);
        (void)hipGetLastError();
        grid = cus;
    }
    if (grid < 0) return;
    if (hipMemsetAsync((char*)d_ws + WS_CTL, 0, ZERO_BYTES, stream) != hipSuccess) { fprintf(stderr, "kernel_launch: hipMemsetAsync failed\n"); return; }
    Args a{};
    for (int i = 0; i < 27; ++i) a.in[i] = (const float*)d_in[i];
    a.out = (float*)d_out; a.ws = (unsigned char*)d_ws; a.pad = 0;
#if MK_MULTI
    for (int p = 0; p < N_PHASES; ++p) { a.ph_lo = p; a.ph_hi = p + 1; a.use_bar = 0;
        hipLaunchKernelGGL(yoco_fwd, dim3(grid), dim3(NWAVES * 64), LDS_BYTES, stream, a); }
#else
    a.ph_lo = 0; a.ph_hi = N_PHASES; a.use_bar = 1;
    hipLaunchKernelGGL(yoco_fwd, dim3(grid), dim3(NWAVES * 64), LDS_BYTES, stream, a);
#endif
    const hipError_t le = hipPeekAtLastError();
    if (le != hipSuccess) fprintf(stderr, "kernel_launch: launch failed: %s\n", hipGetErrorName(le));
}
```
